# Optimizing an MI355X kernel written in HIP

```python
import jax, jax.numpy as jnp
from jax import lax
import numpy as np

D_MODEL = 1024
BATCH = 8
SEQ = 2048
DEPTH = 4

GRID_W = 64
CTX_LEN = 256
ATT_HEADS = 8
ATT_KV_HEADS = 2
ATT_HEAD_DIM = 64
ATT_WIDTH = ATT_HEADS * ATT_HEAD_DIM
KV_WIDTH = ATT_KV_HEADS * ATT_HEAD_DIM
WINDOW = 128
BLOCK = 128
ROPE_BASE = 10000.0
M_HEADS = 4
M_HEAD_DIM = 128
M_WIDTH = M_HEADS * M_HEAD_DIM
CONV_K = 5
CHUNK = 128
N_DIR = 2
MIX_WIDTH = ATT_WIDTH + M_WIDTH
EPS = 1e-6
SPLIT_SIZES = (ATT_WIDTH, KV_WIDTH, KV_WIDTH, ATT_WIDTH, M_WIDTH, M_WIDTH, M_WIDTH, M_WIDTH, M_WIDTH, N_DIR * M_HEADS, N_DIR * M_HEADS)
IN_COLS = 2 * ATT_WIDTH + 2 * KV_WIDTH + 5 * M_WIDTH + 2 * N_DIR * M_HEADS

kernel_name = "hymba_style_window_gqa_bidir_mlstm_prefix_dit"


def rmsnorm(x, g):
    xf = x.astype(jnp.float32)
    y = xf * lax.rsqrt(jnp.mean(xf * xf, axis=-1, keepdims=True) + EPS)
    return (y * g.astype(jnp.float32)).astype(x.dtype)


def project(xn, w_in):
    idx = np.cumsum(SPLIT_SIZES)[:-1].tolist()
    return jnp.split(xn @ w_in, idx, axis=-1)


def axial_rope_tables(T):
    rows = T // GRID_W
    row = jnp.repeat(jnp.arange(rows), GRID_W).astype(jnp.float32)
    col = jnp.tile(jnp.arange(GRID_W), rows).astype(jnp.float32)
    half = ATT_HEAD_DIM // 2
    inv = ROPE_BASE ** (-jnp.arange(0, half, 2, dtype=jnp.float32) / half)
    ang_r = row[:, None] * inv
    ang_c = col[:, None] * inv
    return (jnp.cos(ang_r)[:, None, :], jnp.sin(ang_r)[:, None, :],
            jnp.cos(ang_c)[:, None, :], jnp.sin(ang_c)[:, None, :])


def rope_2d(u, tables):
    cos_r, sin_r, cos_c, sin_c = [t.astype(u.dtype) for t in tables]

    def rot(a, cos, sin):
        a1, a2 = jnp.split(a, 2, axis=-1)
        return jnp.concatenate([a1 * cos - a2 * sin, a2 * cos + a1 * sin], axis=-1)

    ur, uc = jnp.split(u, 2, axis=-1)
    return jnp.concatenate([rot(ur, cos_r, sin_r), rot(uc, cos_c, sin_c)], axis=-1)


def window_ctx_attention(q, k, v, kc, vc, sink):
    B, T, H, dh = q.shape
    G = H // ATT_KV_HEADS
    NB = T // BLOCK
    scale = dh ** -0.5
    qb = q.reshape(B, NB, BLOCK, ATT_KV_HEADS, G, dh)
    pad = ((0, 0), (BLOCK, BLOCK), (0, 0), (0, 0))
    kp = jnp.pad(k, pad).reshape(B, NB + 2, BLOCK, ATT_KV_HEADS, dh)
    vp = jnp.pad(v, pad).reshape(B, NB + 2, BLOCK, ATT_KV_HEADS, dh)
    kw = jnp.concatenate([kp[:, :-2], kp[:, 1:-1], kp[:, 2:]], axis=2)
    vw = jnp.concatenate([vp[:, :-2], vp[:, 1:-1], vp[:, 2:]], axis=2)
    s_win = jnp.einsum('bnqhgd,bnkhd->bhgnqk', qb, kw).astype(jnp.float32) * scale
    qpos = jnp.arange(NB)[:, None, None] * BLOCK + jnp.arange(BLOCK)[None, :, None]
    kpos = (jnp.arange(NB)[:, None, None] - 1) * BLOCK + jnp.arange(3 * BLOCK)[None, None, :]
    valid = (jnp.abs(qpos - kpos) <= WINDOW) & (kpos >= 0) & (kpos < T)
    s_win = jnp.where(valid, s_win, -jnp.inf)
    s_ctx = jnp.einsum('bnqhgd,bchd->bhgnqc', qb, kc).astype(jnp.float32) * scale
    s_sink = jnp.broadcast_to(sink.astype(jnp.float32).reshape(1, ATT_KV_HEADS, G, 1, 1, 1),
                              s_win.shape[:-1] + (1,))
    p = jax.nn.softmax(jnp.concatenate([s_win, s_ctx, s_sink], axis=-1), axis=-1)
    Lw = 3 * BLOCK
    Lc = kc.shape[1]
    p_win = p[..., :Lw].astype(v.dtype)
    p_ctx = p[..., Lw:Lw + Lc].astype(v.dtype)
    out = (jnp.einsum('bhgnqk,bnkhd->bnqhgd', p_win, vw)
           + jnp.einsum('bhgnqc,bchd->bnqhgd', p_ctx, vc))
    return out.reshape(B, T, H * dh)


def ctx_attention(qc, kc, vc, sink):
    B, Lc, H, dh = qc.shape
    G = H // ATT_KV_HEADS
    qg = qc.reshape(B, Lc, ATT_KV_HEADS, G, dh)
    s = jnp.einsum('bqhgd,bkhd->bhgqk', qg, kc).astype(jnp.float32) * dh ** -0.5
    s_sink = jnp.broadcast_to(sink.astype(jnp.float32).reshape(1, ATT_KV_HEADS, G, 1, 1),
                              s.shape[:-1] + (1,))
    p = jax.nn.softmax(jnp.concatenate([s, s_sink], axis=-1), axis=-1)
    out = jnp.einsum('bhgqk,bkhd->bqhgd', p[..., :Lc].astype(vc.dtype), vc)
    return out.reshape(B, Lc, H * dh)


def dwconv(u, w, b):
    C = u.shape[-1]
    y = lax.conv_general_dilated(u, w[:, None, :].astype(u.dtype), window_strides=(1,),
                                 padding=[(CONV_K // 2, CONV_K // 2)],
                                 dimension_numbers=('NWC', 'WIO', 'NWC'), feature_group_count=C)
    return y + b.astype(u.dtype)


def mlstm_init_state(B):
    N = N_DIR * B * M_HEADS
    return (jnp.zeros((N, M_HEAD_DIM, M_HEAD_DIM), jnp.float32),
            jnp.zeros((N, M_HEAD_DIM), jnp.float32),
            jnp.full((N,), -jnp.inf, jnp.float32))


def mlstm_chunkwise(q, k, v, i_pre, f_pre, state):
    N, T, dh = q.shape
    NC = T // CHUNK
    f32 = jnp.float32

    def chunks(u):
        return u.astype(f32).reshape((N, NC, CHUNK) + u.shape[2:]).swapaxes(0, 1)

    qc = chunks(q)
    kc = chunks(k) * dh ** -0.5
    vc = chunks(v)
    lf = chunks(jax.nn.log_sigmoid(f_pre.astype(f32)))
    ic = chunks(i_pre)
    lower = jnp.tril(jnp.ones((CHUNK, CHUNK), bool))

    def step(carry, inp):
        C, n, m = carry
        qq, kk, vv, lfc, ii = inp
        b = jnp.cumsum(lfc, axis=-1)
        dmat = jnp.where(lower, b[:, :, None] - b[:, None, :] + ii[:, None, :], -jnp.inf)
        inter = b + m[:, None]
        m_t = jnp.maximum(inter, jnp.max(dmat, axis=-1))
        w_inter = jnp.exp(inter - m_t)
        qk = jnp.einsum('ntd,nsd->nts', qq, kk) * jnp.exp(dmat - m_t[:, :, None])
        num = (w_inter[..., None] * jnp.einsum('nvd,ntd->ntv', C, qq)
               + jnp.einsum('nts,nsv->ntv', qk, vv))
        den = w_inter * jnp.einsum('nd,ntd->nt', n, qq) + qk.sum(-1)
        h = num / jnp.maximum(jnp.abs(den), jnp.exp(-m_t))[..., None]
        bL = b[:, -1]
        g = bL[:, None] - b + ii
        m_new = jnp.maximum(bL + m, jnp.max(g, axis=-1))
        a = jnp.exp(bL + m - m_new)
        w = jnp.exp(g - m_new[:, None])
        C_new = a[:, None, None] * C + jnp.einsum('ns,nsv,nsd->nvd', w, vv, kk)
        n_new = a[:, None] * n + jnp.einsum('ns,nsd->nd', w, kk)
        return (C_new, n_new, m_new), h

    state, h = lax.scan(step, state, (qc, kc, vc, lf, ic))
    h = h.swapaxes(0, 1).reshape(N, T, dh)
    return h.astype(q.dtype), state


def mlstm_bidir(q, k, v, i_pre, f_pre, state):
    B, T, _ = q.shape

    def heads(u):
        u = u.reshape(B, T, M_HEADS, M_HEAD_DIM).transpose(0, 2, 1, 3)
        return jnp.stack([u, jnp.flip(u, axis=2)]).reshape(N_DIR * B * M_HEADS, T, M_HEAD_DIM)

    def gates(gt):
        gt = gt.reshape(B, T, N_DIR, M_HEADS).transpose(2, 0, 3, 1)
        return jnp.stack([gt[0], jnp.flip(gt[1], axis=-1)]).reshape(N_DIR * B * M_HEADS, T)

    h, state = mlstm_chunkwise(heads(q), heads(k), heads(v), gates(i_pre), gates(f_pre), state)
    h = h.reshape(N_DIR, B, M_HEADS, T, M_HEAD_DIM)
    h = h[0] + jnp.flip(h[1], axis=2)
    return h.transpose(0, 2, 1, 3).reshape(B, T, M_WIDTH), state


def mlstm_post(h, o_pre, z, head_g):
    B, T, _ = h.shape
    h = jax.nn.sigmoid(o_pre) * h
    hh = rmsnorm(h.reshape(B, T, M_HEADS, M_HEAD_DIM), head_g.reshape(M_HEADS, M_HEAD_DIM))
    return hh.reshape(B, T, M_WIDTH) * jax.nn.silu(z)


def mlstm_qk(mq, mk, conv_w, conv_b):
    qk = jax.nn.silu(dwconv(jnp.concatenate([mq, mk], axis=-1), conv_w, conv_b))
    return jnp.split(qk, 2, axis=-1)


def hybrid_layer(x, ctx, mod_x, mod_c, tables, norm_g, w_in, conv_w, conv_b, gate_b, sink,
                 head_g, w_out, last):
    shift_x, scale_x, gate_x = mod_x
    shift_c, scale_c, gate_c = mod_c
    B, T, _ = x.shape
    Lc = ctx.shape[1]
    b_i, b_f = jnp.split(gate_b, 2)
    xn = rmsnorm(x, norm_g) * (1 + scale_x) + shift_x
    cn = rmsnorm(ctx, norm_g) * (1 + scale_c) + shift_c
    aq, ak, av, az, mq, mk, mv, mo, mz, mi, mf = project(xn, w_in)
    caq, cak, cav, caz, cmq, cmk, cmv, cmo, cmz, cmi, cmf = project(cn, w_in)

    q = rope_2d(aq.reshape(B, T, ATT_HEADS, ATT_HEAD_DIM), tables)
    k = rope_2d(ak.reshape(B, T, ATT_KV_HEADS, ATT_HEAD_DIM), tables)
    v = av.reshape(B, T, ATT_KV_HEADS, ATT_HEAD_DIM)
    kc = cak.reshape(B, Lc, ATT_KV_HEADS, ATT_HEAD_DIM)
    vc = cav.reshape(B, Lc, ATT_KV_HEADS, ATT_HEAD_DIM)
    att_x = window_ctx_attention(q, k, v, kc, vc, sink) * jax.nn.silu(az)

    cq, ck = mlstm_qk(cmq, cmk, conv_w, conv_b)
    xq, xk = mlstm_qk(mq, mk, conv_w, conv_b)
    h_ctx, ctx_state = mlstm_bidir(cq, ck, cmv, cmi + b_i, cmf + b_f, mlstm_init_state(B))
    h_lat, _ = mlstm_bidir(xq, xk, mv, mi + b_i, mf + b_f, ctx_state)
    m_x = mlstm_post(h_lat, mo, mz, head_g)

    out_x = jnp.concatenate([att_x, m_x], axis=-1) @ w_out
    x = x + gate_x * out_x
    if not last:
        qc = caq.reshape(B, Lc, ATT_HEADS, ATT_HEAD_DIM)
        att_c = ctx_attention(qc, kc, vc, sink) * jax.nn.silu(caz)
        m_c = mlstm_post(h_ctx, cmo, cmz, head_g)
        out_c = jnp.concatenate([att_c, m_c], axis=-1) @ w_out
        ctx = ctx + gate_c * out_c
    return x, ctx


def setup_inputs(seed: int = 0) -> dict:
    key = jax.random.key(seed)
    ks = jax.random.split(key, 16)
    f32 = jnp.float32
    nrm = lambda k, s: jax.random.normal(k, s, f32)
    f_bias = jnp.tile(jnp.linspace(3.0, 6.0, M_HEADS), N_DIR)
    gate_b = jnp.concatenate([0.1 * nrm(ks[8], (DEPTH, N_DIR * M_HEADS)),
                              f_bias[None, :] + 0.1 * nrm(ks[9], (DEPTH, N_DIR * M_HEADS))], axis=-1)
    return {
        "x": nrm(ks[0], (BATCH, SEQ, D_MODEL)),
        "c": nrm(ks[1], (BATCH, D_MODEL)),
        "ctx": nrm(ks[2], (BATCH, CTX_LEN, D_MODEL)),
        "c_ctx": nrm(ks[3], (D_MODEL,)),
        "w_ada": 0.5 * D_MODEL ** -0.5 * nrm(ks[4], (DEPTH, D_MODEL, 3 * D_MODEL)),
        "b_ada": 0.01 * nrm(ks[5], (DEPTH, 3 * D_MODEL)),
        "norm_g": 1.0 + 0.02 * nrm(ks[6], (DEPTH, D_MODEL)),
        "w_in": D_MODEL ** -0.5 * nrm(ks[7], (DEPTH, D_MODEL, IN_COLS)),
        "conv_w": CONV_K ** -0.5 * nrm(ks[10], (DEPTH, CONV_K, 2 * M_WIDTH)),
        "conv_b": 0.01 * nrm(ks[11], (DEPTH, 2 * M_WIDTH)),
        "gate_b": gate_b,
        "sink": 0.5 * nrm(ks[12], (DEPTH, ATT_HEADS)),
        "head_g": 1.0 + 0.02 * nrm(ks[13], (DEPTH, M_WIDTH)),
        "w_out": MIX_WIDTH ** -0.5 * nrm(ks[14], (DEPTH, MIX_WIDTH, D_MODEL)),
        "final_g": 1.0 + 0.02 * nrm(ks[15], (D_MODEL,)),
    }


def reference(x, c, ctx, c_ctx, w_ada, b_ada, norm_g, w_in, conv_w, conv_b, gate_b, sink,
              head_g, w_out, final_g):
    T = x.shape[1]
    tables = axial_rope_tables(T)
    sc = jax.nn.silu(c)
    scc = jax.nn.silu(c_ctx)
    for l in range(DEPTH):
        mod_x = jnp.split((sc @ w_ada[l] + b_ada[l])[:, None, :], 3, axis=-1)
        mod_c = jnp.split(scc @ w_ada[l] + b_ada[l], 3, axis=-1)
        x, ctx = hybrid_layer(x, ctx, mod_x, mod_c, tables, norm_g[l], w_in[l], conv_w[l],
                              conv_b[l], gate_b[l], sink[l], head_g[l], w_out[l],
                              last=(l == DEPTH - 1))
    return rmsnorm(x, final_g)
```

```cpp
#include <hip/hip_runtime.h>
#include <cstdint>
#include <cstdio>

typedef _Float16 h16;

constexpr int NB = 8, T = 2048, D = 1024, DEPTH = 4, LC = 256;
constexpr int NLAT = NB * T, NCTX = NB * LC, NROW = NLAT + NCTX;
constexpr int INC = 3856, PW = 3840;
constexpr int C_AQ = 0, C_AK = 512, C_AV = 640, C_AZ = 768, C_MQ = 1280, C_MK = 1792, C_MV = 2304, C_MO = 2816, C_MZ = 3328, C_MI = 3840;
constexpr float EPS = 1e-6f;

__device__ __forceinline__ float silu_f(float x) { return x / (1.f + expf(-x)); }
__device__ __forceinline__ float sigmoid_f(float x) { return 1.f / (1.f + expf(-x)); }
__device__ __forceinline__ float wave_sum(float v) {
#pragma unroll
    for (int o = 1; o < 64; o <<= 1) v += __shfl_xor(v, o);
    return v;
}

__global__ void __launch_bounds__(256) mod_kernel(const float* __restrict__ c, const float* __restrict__ c_ctx, const float* __restrict__ w_ada,
                                                  const float* __restrict__ b_ada, float* __restrict__ MOD) {
    __shared__ float sc[9][1024];
    for (int i = threadIdx.x; i < 9 * 1024; i += 256) { const int r = i >> 10, k = i & 1023; const float v = (r < 8) ? c[r * 1024 + k] : c_ctx[k]; sc[r][k] = silu_f(v); }
    __syncthreads();
    const int gj = blockIdx.x * 256 + threadIdx.x; const int l = gj / 3072, j = gj % 3072;
    const float* w = w_ada + (size_t)l * 1024 * 3072 + j;
    float a0 = 0, a1 = 0, a2 = 0, a3 = 0, a4 = 0, a5 = 0, a6 = 0, a7 = 0, a8 = 0;
    for (int k = 0; k < 1024; ++k) { const float wv = w[(size_t)k * 3072];
        a0 += sc[0][k] * wv; a1 += sc[1][k] * wv; a2 += sc[2][k] * wv; a3 += sc[3][k] * wv; a4 += sc[4][k] * wv; a5 += sc[5][k] * wv; a6 += sc[6][k] * wv; a7 += sc[7][k] * wv; a8 += sc[8][k] * wv; }
    const float bb = b_ada[l * 3072 + j]; float* o = MOD + (size_t)l * 9 * 3072 + j;
    o[0 * 3072] = a0 + bb; o[1 * 3072] = a1 + bb; o[2 * 3072] = a2 + bb; o[3 * 3072] = a3 + bb; o[4 * 3072] = a4 + bb; o[5 * 3072] = a5 + bb; o[6 * 3072] = a6 + bb; o[7 * 3072] = a7 + bb; o[8 * 3072] = a8 + bb;
}

__global__ void __launch_bounds__(256) norm_kernel(const float* __restrict__ xlat, const float* __restrict__ xctx, const float* __restrict__ MODl,
                                                   const float* __restrict__ g, h16* __restrict__ XN) {
    const int row = blockIdx.x * 4 + (threadIdx.x >> 6), lane = threadIdx.x & 63;
    const float* xr = row < NLAT ? xlat + (size_t)row * D : xctx + (size_t)(row - NLAT) * D;
    const int mr = row < NLAT ? (row >> 11) : 8;
    const float* shift = MODl + mr * 3072; const float* scale = shift + 1024;
    float4 v[4]; float ss = 0.f;
#pragma unroll
    for (int j = 0; j < 4; ++j) { v[j] = *(const float4*)(xr + (j * 64 + lane) * 4); ss += v[j].x * v[j].x + v[j].y * v[j].y + v[j].z * v[j].z + v[j].w * v[j].w; }
    ss = wave_sum(ss);
    const float rstd = 1.0f / sqrtf(ss * (1.f / D) + EPS);
#pragma unroll
    for (int j = 0; j < 4; ++j) { const int k = (j * 64 + lane) * 4;
        const float4 gg = *(const float4*)(g + k), sc = *(const float4*)(scale + k), sh = *(const float4*)(shift + k);
        h16* o = XN + (size_t)row * D + k;
        o[0] = (h16)(v[j].x * rstd * gg.x * (1.f + sc.x) + sh.x); o[1] = (h16)(v[j].y * rstd * gg.y * (1.f + sc.y) + sh.y);
        o[2] = (h16)(v[j].z * rstd * gg.z * (1.f + sc.z) + sh.z); o[3] = (h16)(v[j].w * rstd * gg.w * (1.f + sc.w) + sh.w); }
}

struct EpiProj {
    h16* P; float* GATES; const float* gate_b;
    __device__ __forceinline__ void operator()(int r, int c, float v) const {
        if (c < PW) P[(size_t)r * PW + c] = (h16)v; else GATES[(size_t)r * 16 + (c - PW)] = v + gate_b[c - PW];
    }
};
struct EpiRes {
    float* xlat; float* xctx; const float* MODl;
    __device__ __forceinline__ void operator()(int r, int c, float v) const {
        float* xp = r < NLAT ? xlat + (size_t)r * D + c : xctx + (size_t)(r - NLAT) * D + c;
        const int mr = r < NLAT ? (r >> 11) : 8;
        *xp = *xp + MODl[mr * 3072 + 2048 + c] * v;
    }
};
template <class Epi> __global__ void __launch_bounds__(256) gemm_naive(const h16* __restrict__ A, const float* __restrict__ W, int M, int N, int K, Epi epi) {
    __shared__ float As[16][68]; __shared__ float Bs[16][68];
    const int tx = threadIdx.x & 15, ty = threadIdx.x >> 4; const int m0 = blockIdx.y * 64, n0 = blockIdx.x * 64;
    float acc[4][4];
#pragma unroll
    for (int i = 0; i < 4; ++i)
#pragma unroll
        for (int j = 0; j < 4; ++j) acc[i][j] = 0.f;
    for (int k0 = 0; k0 < K; k0 += 16) {
        { const int r = threadIdx.x >> 2, kq = (threadIdx.x & 3) * 4; const h16* ap = A + (size_t)(m0 + r) * K + k0 + kq;
#pragma unroll
          for (int i = 0; i < 4; ++i) As[kq + i][r] = (float)ap[i]; }
        { const int kk = threadIdx.x >> 4, nq = (threadIdx.x & 15) * 4;
#pragma unroll
          for (int i = 0; i < 4; ++i) { const int n = n0 + nq + i; Bs[kk][nq + i] = n < N ? W[(size_t)(k0 + kk) * N + n] : 0.f; } }
        __syncthreads();
#pragma unroll
        for (int kk = 0; kk < 16; ++kk) { const float4 a = *(const float4*)&As[kk][ty * 4]; const float4 b = *(const float4*)&Bs[kk][tx * 4];
            acc[0][0] += a.x * b.x; acc[0][1] += a.x * b.y; acc[0][2] += a.x * b.z; acc[0][3] += a.x * b.w;
            acc[1][0] += a.y * b.x; acc[1][1] += a.y * b.y; acc[1][2] += a.y * b.z; acc[1][3] += a.y * b.w;
            acc[2][0] += a.z * b.x; acc[2][1] += a.z * b.y; acc[2][2] += a.z * b.z; acc[2][3] += a.z * b.w;
            acc[3][0] += a.w * b.x; acc[3][1] += a.w * b.y; acc[3][2] += a.w * b.z; acc[3][3] += a.w * b.w; }
        __syncthreads();
    }
#pragma unroll
    for (int i = 0; i < 4; ++i)
#pragma unroll
        for (int j = 0; j < 4; ++j) { const int r = m0 + ty * 4 + i, c = n0 + tx * 4 + j; if (c < N) epi(r, c, acc[i][j]); }
}

__global__ void __launch_bounds__(256) rope_kernel(h16* __restrict__ P) {
    const int idx = blockIdx.x * 256 + threadIdx.x;
    const int r = idx / 320, rem = idx % 320, hs = rem >> 5, hf = (rem >> 4) & 1, i = rem & 15;
    const int t = r & (T - 1);
    const int base = (hs < 8 ? hs * 64 : C_AK + (hs - 8) * 64) + hf * 32;
    h16* p = P + (size_t)r * PW + base;
    const float a1 = (float)p[i], a2 = (float)p[16 + i];
    const float pos = (float)(hf == 0 ? (t >> 6) : (t & 63));
    const float inv = powf(10000.0f, -(float)i / 16.0f);
    const float ang = pos * inv; const float cs = cosf(ang), sn = sinf(ang);
    p[i] = (h16)(a1 * cs - a2 * sn); p[16 + i] = (h16)(a2 * cs + a1 * sn);
}

__global__ void __launch_bounds__(256) attn_naive(const h16* __restrict__ P, const float* __restrict__ sink, h16* __restrict__ MIX) {
    const int idx = blockIdx.x * 256 + threadIdx.x; const int hq = idx >> 14, r = idx & (NLAT - 1);
    const int b = r >> 11, t = r & (T - 1), hkv = hq >> 2;
    float q[64], o[64];
    { const h16* qp = P + (size_t)r * PW + C_AQ + hq * 64;
#pragma unroll
      for (int d = 0; d < 64; ++d) { q[d] = (float)qp[d] * 0.125f; o[d] = 0.f; } }
    float m = sink[hq], l = 1.0f;
    const int j0 = t - 128 < 0 ? 0 : t - 128, j1 = t + 128 > T - 1 ? T - 1 : t + 128;
    const int nwin = j1 - j0 + 1;
    for (int jj = 0; jj < nwin + LC; ++jj) {
        const size_t kr = jj < nwin ? (size_t)(b * T + j0 + jj) : (size_t)(NLAT + b * LC + (jj - nwin));
        const h16* kp = P + kr * PW + C_AK + hkv * 64; const h16* vp = P + kr * PW + C_AV + hkv * 64;
        float s = 0.f;
#pragma unroll
        for (int d = 0; d < 64; ++d) s += q[d] * (float)kp[d];
        const float mn = fmaxf(m, s); const float f = expf(m - mn), p = expf(s - mn);
        l = l * f + p; m = mn;
#pragma unroll
        for (int d = 0; d < 64; ++d) o[d] = o[d] * f + p * (float)vp[d];
    }
    const float il = 1.f / l; const h16* zp = P + (size_t)r * PW + C_AZ + hq * 64; h16* op = MIX + (size_t)r * D + hq * 64;
#pragma unroll
    for (int d = 0; d < 64; ++d) op[d] = (h16)(o[d] * il * silu_f((float)zp[d]));
}
__global__ void __launch_bounds__(256) ctx_attn_naive(const h16* __restrict__ P, const float* __restrict__ sink, h16* __restrict__ MIX) {
    const int idx = blockIdx.x * 256 + threadIdx.x; const int hq = idx >> 11, rc = idx & (NCTX - 1);
    const int r = NLAT + rc, b = rc >> 8, hkv = hq >> 2;
    float q[64], o[64];
    { const h16* qp = P + (size_t)r * PW + C_AQ + hq * 64;
#pragma unroll
      for (int d = 0; d < 64; ++d) { q[d] = (float)qp[d] * 0.125f; o[d] = 0.f; } }
    float m = sink[hq], l = 1.0f;
    for (int jj = 0; jj < LC; ++jj) {
        const size_t kr = (size_t)(NLAT + b * LC + jj);
        const h16* kp = P + kr * PW + C_AK + hkv * 64; const h16* vp = P + kr * PW + C_AV + hkv * 64;
        float s = 0.f;
#pragma unroll
        for (int d = 0; d < 64; ++d) s += q[d] * (float)kp[d];
        const float mn = fmaxf(m, s); const float f = expf(m - mn), p = expf(s - mn);
        l = l * f + p; m = mn;
#pragma unroll
        for (int d = 0; d < 64; ++d) o[d] = o[d] * f + p * (float)vp[d];
    }
    const float il = 1.f / l; const h16* zp = P + (size_t)r * PW + C_AZ + hq * 64; h16* op = MIX + (size_t)r * D + hq * 64;
#pragma unroll
    for (int d = 0; d < 64; ++d) op[d] = (h16)(o[d] * il * silu_f((float)zp[d]));
}

__global__ void __launch_bounds__(256) conv_kernel(const h16* __restrict__ P, const float* __restrict__ cw, const float* __restrict__ cb, h16* __restrict__ CQK) {
    const size_t idx = (size_t)blockIdx.x * 256 + threadIdx.x; const int r = (int)(idx >> 10), c = (int)(idx & 1023);
    int t, len; if (r < NLAT) { t = r & (T - 1); len = T; } else { t = (r - NLAT) & (LC - 1); len = LC; }
    float y = cb[c];
#pragma unroll
    for (int j = 0; j < 5; ++j) { const int tt = t + j - 2; if (tt >= 0 && tt < len) y += cw[j * 1024 + c] * (float)P[(size_t)(r + j - 2) * PW + C_MQ + c]; }
    CQK[(size_t)r * 1024 + c] = (h16)silu_f(y);
}

__global__ void __launch_bounds__(256) mlstm_naive(const h16* __restrict__ P, const h16* __restrict__ CQK, const float* __restrict__ GATES, float* __restrict__ H) {
    __shared__ float sq[16][128], sk[16][128], sv[16][32], sig[16], sfg[16]; __shared__ int srow[16];
    const int tid = threadIdx.x; const int slice = blockIdx.x & 3, head = (blockIdx.x >> 2) & 3, b = blockIdx.x >> 4;
    const int vl = tid >> 3, kg = tid & 7;
    for (int dir = 0; dir < 2; ++dir) {
        float C[16], n[16]; float m = -INFINITY;
#pragma unroll
        for (int i = 0; i < 16; ++i) { C[i] = 0.f; n[i] = 0.f; }
        for (int p0 = 0; p0 < LC + T; p0 += 16) {
            __syncthreads();
            for (int e = tid; e < 16 * 128; e += 256) { const int s = e >> 7, d = e & 127; const int p = p0 + s;
                int row; if (p < LC) { const int tc = dir == 0 ? p : LC - 1 - p; row = NLAT + b * LC + tc; } else { const int pl = p - LC; const int tt = dir == 0 ? pl : T - 1 - pl; row = b * T + tt; }
                sq[s][d] = (float)CQK[(size_t)row * 1024 + head * 128 + d];
                sk[s][d] = (float)CQK[(size_t)row * 1024 + 512 + head * 128 + d] * 0.08838834764831845f;
                if (d < 32) sv[s][d] = (float)P[(size_t)row * PW + C_MV + head * 128 + slice * 32 + d];
                if (d == 0) { sig[s] = GATES[(size_t)row * 16 + dir * 4 + head]; sfg[s] = GATES[(size_t)row * 16 + 8 + dir * 4 + head]; srow[s] = row; } }
            __syncthreads();
            for (int s = 0; s < 16; ++s) {
                const float fp = sfg[s], ip = sig[s];
                const float lf = fminf(fp, 0.f) - log1pf(expf(-fabsf(fp)));
                const float mn = fmaxf(lf + m, ip);
                const float fs = expf(lf + m - mn), is_ = expf(ip - mn);
                const float vv = sv[s][vl] * is_;
                float num = 0.f, den = 0.f;
#pragma unroll
                for (int i = 0; i < 16; ++i) { const float kk = sk[s][kg + 8 * i], qq = sq[s][kg + 8 * i];
                    C[i] = fs * C[i] + vv * kk; n[i] = fs * n[i] + is_ * kk; num += C[i] * qq; den += n[i] * qq; }
                num += __shfl_xor(num, 1); num += __shfl_xor(num, 2); num += __shfl_xor(num, 4);
                den += __shfl_xor(den, 1); den += __shfl_xor(den, 2); den += __shfl_xor(den, 4);
                const float h = num / fmaxf(fabsf(den), expf(-mn));
                m = mn;
                if (kg == 0) { float* hp = H + (size_t)srow[s] * 512 + head * 128 + slice * 32 + vl; if (dir == 0) *hp = h; else *hp = *hp + h; }
            }
        }
    }
}

__global__ void __launch_bounds__(256) post_kernel(const h16* __restrict__ P, const float* __restrict__ H, const float* __restrict__ hg, h16* __restrict__ MIX) {
    const int w = blockIdx.x * 4 + (threadIdx.x >> 6), lane = threadIdx.x & 63; const int r = w >> 2, head = w & 3;
    const int c0 = head * 128 + lane, c1 = c0 + 64;
    const float h0 = sigmoid_f((float)P[(size_t)r * PW + C_MO + c0]) * H[(size_t)r * 512 + c0];
    const float h1 = sigmoid_f((float)P[(size_t)r * PW + C_MO + c1]) * H[(size_t)r * 512 + c1];
    const float ms = wave_sum(h0 * h0 + h1 * h1) * (1.f / 128.f);
    const float rstd = 1.0f / sqrtf(ms + EPS);
    MIX[(size_t)r * D + 512 + c0] = (h16)(h0 * rstd * hg[c0] * silu_f((float)P[(size_t)r * PW + C_MZ + c0]));
    MIX[(size_t)r * D + 512 + c1] = (h16)(h1 * rstd * hg[c1] * silu_f((float)P[(size_t)r * PW + C_MZ + c1]));
}

__global__ void __launch_bounds__(256) final_kernel(float* __restrict__ x, const float* __restrict__ g) {
    const int row = blockIdx.x * 4 + (threadIdx.x >> 6), lane = threadIdx.x & 63;
    float* xr = x + (size_t)row * D;
    float4 v[4]; float ss = 0.f;
#pragma unroll
    for (int j = 0; j < 4; ++j) { v[j] = *(const float4*)(xr + (j * 64 + lane) * 4); ss += v[j].x * v[j].x + v[j].y * v[j].y + v[j].z * v[j].z + v[j].w * v[j].w; }
    ss = wave_sum(ss);
    const float rstd = 1.0f / sqrtf(ss * (1.f / D) + EPS);
#pragma unroll
    for (int j = 0; j < 4; ++j) { const int k = (j * 64 + lane) * 4; const float4 gg = *(const float4*)(g + k);
        float4 o; o.x = v[j].x * rstd * gg.x; o.y = v[j].y * rstd * gg.y; o.z = v[j].z * rstd * gg.z; o.w = v[j].w * rstd * gg.w; *(float4*)(xr + k) = o; }
}

extern "C" void kernel_launch(void* const* d_in, const int* in_sizes, int n_in, void* d_out, int out_size, void* d_ws, size_t ws_size, hipStream_t stream) {
    const float* x = (const float*)d_in[0]; const float* c = (const float*)d_in[1]; const float* ctx = (const float*)d_in[2]; const float* c_ctx = (const float*)d_in[3];
    const float* w_ada = (const float*)d_in[4]; const float* b_ada = (const float*)d_in[5]; const float* norm_g = (const float*)d_in[6]; const float* w_in = (const float*)d_in[7];
    const float* conv_w = (const float*)d_in[8]; const float* conv_b = (const float*)d_in[9]; const float* gate_b = (const float*)d_in[10]; const float* sink = (const float*)d_in[11];
    const float* head_g = (const float*)d_in[12]; const float* w_out = (const float*)d_in[13]; const float* final_g = (const float*)d_in[14];
    float* out = (float*)d_out;
    unsigned char* ws = (unsigned char*)d_ws; size_t off = 0;
    auto carve = [&](size_t bytes) { unsigned char* p = ws + off; off += (bytes + 255) & ~(size_t)255; return p; };
    h16* P = (h16*)carve((size_t)NROW * PW * 2);
    h16* XN = (h16*)carve((size_t)NROW * D * 2);
    h16* MIX = XN;
    float* XC = (float*)carve((size_t)NCTX * D * 4);
    h16* CQK = (h16*)carve((size_t)NROW * 1024 * 2);
    float* H = (float*)carve((size_t)NROW * 512 * 4);
    float* GATES = (float*)carve((size_t)NROW * 16 * 4);
    float* MOD = (float*)carve((size_t)DEPTH * 9 * 3072 * 4);
    if (off > ws_size) { fprintf(stderr, "kernel_launch: workspace too small: need %zu have %zu\n", off, ws_size); return; }

    (void)hipMemcpyAsync(out, x, (size_t)NLAT * D * 4, hipMemcpyDeviceToDevice, stream);
    (void)hipMemcpyAsync(XC, ctx, (size_t)NCTX * D * 4, hipMemcpyDeviceToDevice, stream);
    mod_kernel<<<DEPTH * 3072 / 256, 256, 0, stream>>>(c, c_ctx, w_ada, b_ada, MOD);
    for (int l = 0; l < DEPTH; ++l) {
        const bool last = (l == DEPTH - 1);
        const float* MODl = MOD + (size_t)l * 9 * 3072;
        norm_kernel<<<NROW / 4, 256, 0, stream>>>(out, XC, MODl, norm_g + l * D, XN);
        { EpiProj e{P, GATES, gate_b + l * 16}; dim3 g((INC + 63) / 64, NROW / 64);
          gemm_naive<EpiProj><<<g, 256, 0, stream>>>(XN, w_in + (size_t)l * D * INC, NROW, INC, D, e); }
        rope_kernel<<<NLAT * 320 / 256, 256, 0, stream>>>(P);
        conv_kernel<<<NROW * 1024 / 256, 256, 0, stream>>>(P, conv_w + (size_t)l * 5 * 1024, conv_b + l * 1024, CQK);
        attn_naive<<<NLAT * 8 / 256, 256, 0, stream>>>(P, sink + l * 8, MIX);
        if (!last) ctx_attn_naive<<<NCTX * 8 / 256, 256, 0, stream>>>(P, sink + l * 8, MIX);
        mlstm_naive<<<NB * 4 * 4, 256, 0, stream>>>(P, CQK, GATES, H);
        post_kernel<<<NROW, 256, 0, stream>>>(P, H, head_g + l * 512, MIX);
        { EpiRes e{out, XC, MODl}; const int M = last ? NLAT : NROW; dim3 g(D / 64, M / 64);
          gemm_naive<EpiRes><<<g, 256, 0, stream>>>(MIX, w_out + (size_t)l * D * D, M, D, D, e); }
    }
    final_kernel<<<NLAT / 4, 256, 0, stream>>>(out, final_g);
}
```

```cpp
#include <hip/hip_runtime.h>
#include <cstdint>
#include <cstdio>

typedef _Float16 h16;

constexpr int NB = 8, T = 2048, D = 1024, DEPTH = 4, LC = 256;
constexpr int NLAT = NB * T, NCTX = NB * LC, NROW = NLAT + NCTX;
constexpr int INC = 3856, PW = 3840, NPAD = 4096;
constexpr int C_AQ = 0, C_AK = 512, C_AV = 640, C_AZ = 768, C_MQ = 1280, C_MK = 1792, C_MV = 2304, C_MO = 2816, C_MZ = 3328, C_MI = 3840;
constexpr float EPS = 1e-6f;
constexpr int NTHR = 512, NWAVES = 8;

typedef _Float16 h16x2 __attribute__((ext_vector_type(2)));
__device__ __forceinline__ unsigned pkh(float lo, float hi) { h16x2 v = {(h16)lo, (h16)hi}; return __builtin_bit_cast(unsigned, v); }

namespace pg8 {
#define PG8_LAS __attribute__((address_space(3)))
typedef unsigned short bf16_t;
typedef short bf16x8 __attribute__((ext_vector_type(8)));
typedef float f32x4 __attribute__((ext_vector_type(4)));
typedef unsigned u32x4 __attribute__((ext_vector_type(4)));
typedef _Float16 h16x8 __attribute__((ext_vector_type(8)));
constexpr int BM = 256, BK = 64, HALF = 128, HTB = HALF * BK * 2  , STAGE_BYTES = 8 * HTB, NXCD = 8, WGM = 8;

__host__ __device__ __forceinline__ int lds_byte(int r, int c) { const int st = (r >> 4) * 2 + (c >> 5), rr = r & 15, cc = c & 31, ob = rr * 64 + cc * 2; return st * 1024 + (ob ^ (((ob >> 9) & 1) << 5)); }
__host__ __device__ __forceinline__ void stage_rc(int b, int& R, int& C) { const int st = b / 1024, sb = b % 1024, swz = sb ^ (((sb >> 9) & 1) << 5); R = (st >> 1) * 16 + swz / 64; C = (st & 1) * 32 + (swz % 64) / 2; }
__host__ __device__ __forceinline__ int perm32(int rho) { const int n = rho >> 4, i = rho & 15; return 8 * (i >> 2) + 4 * n + (i & 3); }

struct Unit { int pm, pn; };
struct Gemm { const bf16_t* A; const bf16_t* Bt; int M, N, K; };

struct StaticOrder {
    int nM, nN, nwg, G, c;
    __host__ __device__ void init(int M, int N, int G_, int c_) { nM = M / BM; nN = N / BM; nwg = nM * nN; G = G_; c = c_; }
    __host__ __device__ bool next(int i, Unit& u) const {
        const long L = (long)i * G + c; if (L >= nwg) return false;
        int wgid = (int)L; { const int q = nwg / NXCD, r = nwg % NXCD, xcd = wgid % NXCD, off = wgid / NXCD; wgid = (xcd < r ? xcd * (q + 1) : r * (q + 1) + (xcd - r) * q) + off; }
        const int nig = WGM * nN, gid = wgid / nig, fm = gid * WGM, gsz = (nM - fm) < WGM ? (nM - fm) : WGM;
        u.pm = fm + ((wgid % nig) % gsz); u.pn = (wgid % nig) / gsz; return true;
    }
    __device__ __forceinline__ void a_ready(const Unit&) const {}
    __device__ __forceinline__ void done(const Unit&) const {}
};

struct EpiProjH {
    static constexpr bool PERM = true, AFTER_DRAIN = false;
    h16* P; float* GATES; const float* gate_b;
    __device__ __forceinline__ void operator()(const f32x4 (&acc)[2][2][4][2], const Unit& u, int wr, int wc, int fr, int fq) const {
        const int row0 = u.pm * BM + wr * 64 + fr;
        if (u.pn < 15) {
            const int col0 = u.pn * BM + wc * 32 + 8 * fq;
#pragma unroll
            for (int ai = 0; ai < 2; ++ai)
#pragma unroll
                for (int m = 0; m < 4; ++m) { h16* rowp = P + (size_t)(row0 + ai * HALF + m * 16) * PW + col0;
#pragma unroll
                    for (int bj = 0; bj < 2; ++bj) { const f32x4 v0 = acc[ai][bj][m][0], v1 = acc[ai][bj][m][1];
                        u32x4 w; w.x = pkh(v0[0], v0[1]); w.y = pkh(v0[2], v0[3]); w.z = pkh(v1[0], v1[1]); w.w = pkh(v1[2], v1[3]);
                        *(u32x4*)(rowp + bj * HALF) = w; } }
        } else if (wc == 0 && fq < 2) {
            const f32x4 b0 = *(const f32x4*)(gate_b + 8 * fq), b1 = *(const f32x4*)(gate_b + 8 * fq + 4);
#pragma unroll
            for (int ai = 0; ai < 2; ++ai)
#pragma unroll
                for (int m = 0; m < 4; ++m) { float* gp = GATES + (size_t)(row0 + ai * HALF + m * 16) * 16 + 8 * fq;
                    *(f32x4*)gp = acc[ai][0][m][0] + b0; *(f32x4*)(gp + 4) = acc[ai][0][m][1] + b1; }
        }
    }
};
struct EpiResF {
    static constexpr bool PERM = false, AFTER_DRAIN = false;
    const float* xin_lat; const float* xin_ctx; float* xout_lat; float* xout_ctx; const float* MODl;
    __device__ __forceinline__ void operator()(const f32x4 (&acc)[2][2][4][2], const Unit& u, int wr, int wc, int fr, int fq) const {
        const int row0 = u.pm * BM + wr * 64 + fr, col0 = u.pn * BM + wc * 32 + 4 * fq;
#pragma unroll
        for (int ai = 0; ai < 2; ++ai)
#pragma unroll
            for (int m = 0; m < 4; ++m) { const int r = row0 + ai * HALF + m * 16;
                const float* xi = r < NLAT ? xin_lat + (size_t)r * D : xin_ctx + (size_t)(r - NLAT) * D;
                float* xo = r < NLAT ? xout_lat + (size_t)r * D : xout_ctx + (size_t)(r - NLAT) * D;
                const float* gate = MODl + (r < NLAT ? (r >> 11) : 8) * 3072 + 2048;
#pragma unroll
                for (int bj = 0; bj < 2; ++bj)
#pragma unroll
                    for (int n = 0; n < 2; ++n) { const int c = col0 + bj * HALF + n * 16;
                        const f32x4 xv = *(const f32x4*)(xi + c), gv = *(const f32x4*)(gate + c);
                        *(f32x4*)(xo + c) = xv + gv * acc[ai][bj][m][n]; } }
    }
};

template <class Epi, class Sched, bool ALIGN_EPI = false, bool SP2 = false>
__device__ __forceinline__ void gemm_phase(PG8_LAS unsigned char* lds, const Gemm g, const Sched& S, const Epi& E) {
    int tid_l = threadIdx.x; asm volatile("" : "+v"(tid_l));
    const int tid = tid_l, wid = __builtin_amdgcn_readfirstlane(tid >> 6), lane = tid & 63, wr = wid >> 2, wc = wid & 3, fr = lane & 15, fq = lane >> 4;
    const int K = g.K, nt = K / BK;
    unsigned voffA[2], voffB[2];
#pragma unroll
    for (int i = 0; i < 2; ++i) { int R, C; stage_rc(tid * 16 + i * 8192, R, C); const int Rb = Epi::PERM ? ((R & ~31) + perm32(R & 31)) : R;
        voffA[i] = (unsigned)(R * K + C) * 2u; voffB[i] = (unsigned)(Rb * K + C) * 2u; }
    const size_t kstep = (size_t)(BK * 2);
    const size_t hstep = (size_t)HALF * K * 2;
    const size_t tstep = 2 * hstep;
    const unsigned ldsw = (unsigned)wid * 1024u;
    const int aoff = lds_byte(wr * 64 + fr, fq * 8), boff = lds_byte(wc * 32 + fr, fq * 8);
#define PG8_SA(b, h) (((b) * 2 + (h)) * HTB)
#define PG8_SB(b, h) ((4 + (b) * 2 + (h)) * HTB)
#define PG8_STAGE(bufoff, gbase, voff) do { _Pragma("unroll") for (int _i = 0; _i < 2; ++_i) \
        __builtin_amdgcn_global_load_lds((const unsigned*)((const char*)(gbase) + (voff)[_i]), (PG8_LAS unsigned*)(lds + (bufoff) + ldsw + _i * 8192), 16, 0, 0); } while (0)
#define PG8_LDA(dst, b, h) do { _Pragma("unroll") for (int m = 0; m < 4; ++m) _Pragma("unroll") for (int k = 0; k < 2; ++k) dst[m][k] = *(const PG8_LAS h16x8*)(lds + PG8_SA(b, h) + aoff + m * 2048 + k * 1024); } while (0)
#define PG8_LDB(dst, b, h) do { _Pragma("unroll") for (int n = 0; n < 2; ++n) _Pragma("unroll") for (int k = 0; k < 2; ++k) dst[n][k] = *(const PG8_LAS h16x8*)(lds + PG8_SB(b, h) + boff + n * 2048 + k * 1024); } while (0)
#define PG8_MMA(ai, bj, At, Bt) do { __builtin_amdgcn_s_setprio(1); _Pragma("unroll") for (int m = 0; m < 4; ++m) _Pragma("unroll") for (int n = 0; n < 2; ++n) _Pragma("unroll") for (int k = 0; k < 2; ++k) \
        acc[ai][bj][m][n] = __builtin_amdgcn_mfma_f32_16x16x32_f16(Bt[n][k], At[m][k], acc[ai][bj][m][n], 0, 0, 0); __builtin_amdgcn_s_setprio(0); } while (0)
#define PG8_WAIT_V(n) asm volatile("s_waitcnt vmcnt(" #n ")" ::: "memory")
#define PG8_WAIT_L(n) asm volatile("s_waitcnt lgkmcnt(" #n ")" ::: "memory")
#define PG8_BAR __builtin_amdgcn_s_barrier()
#define PG8_SCHED __builtin_amdgcn_sched_barrier(0)
    Unit cur, nxt; int ui = 0;
    if (!S.next(0, cur)) return;
    f32x4 acc[2][2][4][2];
#pragma unroll
    for (int a = 0; a < 2; ++a)
#pragma unroll
        for (int b = 0; b < 2; ++b)
#pragma unroll
            for (int m = 0; m < 4; ++m)
#pragma unroll
                for (int n = 0; n < 2; ++n) acc[a][b][m][n] = (f32x4){0.f, 0.f, 0.f, 0.f};
    h16x8 At[4][2], B0[2][2], B1[2][2];
    const char* cA = (const char*)g.A + (size_t)cur.pm * tstep; const char* cB = (const char*)g.Bt + (size_t)cur.pn * tstep;
    S.a_ready(cur);
    if constexpr (SP2) {
        PG8_STAGE(PG8_SB(0, 0), cB, voffB); PG8_STAGE(PG8_SB(0, 1), cB + hstep, voffB); PG8_STAGE(PG8_SA(0, 0), cA, voffA); PG8_STAGE(PG8_SA(0, 1), cA + hstep, voffA);
        if (wr == 1) PG8_BAR;
        PG8_WAIT_V(2); PG8_BAR;
        PG8_STAGE(PG8_SB(1, 0), cB + kstep, voffB); PG8_STAGE(PG8_SA(1, 0), cA + kstep, voffA); PG8_STAGE(PG8_SB(1, 1), cB + hstep + kstep, voffB);
        PG8_WAIT_V(6); PG8_BAR;
    } else {
        PG8_STAGE(PG8_SB(0, 0), cB, voffB); PG8_STAGE(PG8_SA(0, 0), cA, voffA); PG8_STAGE(PG8_SB(0, 1), cB + hstep, voffB); PG8_STAGE(PG8_SA(0, 1), cA + hstep, voffA);
        if (wr == 1) PG8_BAR;
        PG8_WAIT_V(4); PG8_BAR;
        PG8_STAGE(PG8_SB(1, 0), cB + kstep, voffB); PG8_STAGE(PG8_SA(1, 0), cA + kstep, voffA); PG8_STAGE(PG8_SB(1, 1), cB + hstep + kstep, voffB);
        PG8_WAIT_V(6); PG8_BAR;
    }
    for (;;) {
        const bool has_next = S.next(ui + 1, nxt);
        const char* nA = has_next ? (const char*)g.A + (size_t)nxt.pm * tstep : cA; const char* nB = has_next ? (const char*)g.Bt + (size_t)nxt.pn * tstep : cB;
        for (int t = 0; t < nt; t += 2) {
            const bool last = (t == nt - 2);
            const char* a1 = cA + (size_t)(t + 1) * kstep;
            const char* a2 = last ? nA : cA + (size_t)(t + 2) * kstep; const char* b2 = last ? nB : cB + (size_t)(t + 2) * kstep;
            const char* a3 = a2 + kstep; const char* b3 = b2 + kstep;
            if (last && has_next) S.a_ready(nxt);
            if constexpr (SP2) {
            PG8_LDB(B0, 0, 0); PG8_LDB(B1, 0, 1); PG8_SCHED; PG8_LDA(At, 0, 0); PG8_STAGE(PG8_SA(1, 1), a1 + hstep, voffA);
            PG8_WAIT_V(8); PG8_WAIT_L(0); PG8_BAR; PG8_MMA(0, 0, At, B0); PG8_MMA(0, 1, At, B1); PG8_BAR; PG8_SCHED;
            PG8_LDA(At, 0, 1); PG8_STAGE(PG8_SB(0, 0), b2, voffB); PG8_STAGE(PG8_SB(0, 1), b2 + hstep, voffB); PG8_STAGE(PG8_SA(0, 0), a2, voffA);
            PG8_WAIT_V(8); PG8_WAIT_L(0); PG8_BAR; PG8_MMA(1, 0, At, B0); PG8_MMA(1, 1, At, B1); PG8_BAR; PG8_SCHED;
            PG8_LDB(B0, 1, 0); PG8_LDB(B1, 1, 1); PG8_SCHED; PG8_LDA(At, 1, 0); PG8_STAGE(PG8_SA(0, 1), a2 + hstep, voffA);
            PG8_WAIT_V(8); PG8_WAIT_L(0); PG8_BAR; PG8_MMA(0, 0, At, B0); PG8_MMA(0, 1, At, B1); PG8_BAR; PG8_SCHED;
            PG8_LDA(At, 1, 1); PG8_STAGE(PG8_SB(1, 0), b3, voffB); PG8_STAGE(PG8_SB(1, 1), b3 + hstep, voffB); PG8_STAGE(PG8_SA(1, 0), a3, voffA);
            PG8_WAIT_V(8); PG8_WAIT_L(0); PG8_BAR; PG8_MMA(1, 0, At, B0); PG8_MMA(1, 1, At, B1); PG8_BAR; PG8_SCHED;
            } else {
            PG8_LDB(B0, 0, 0); PG8_SCHED; PG8_LDA(At, 0, 0); PG8_STAGE(PG8_SA(1, 1), a1 + hstep, voffA);
            PG8_WAIT_L(8); PG8_BAR; PG8_WAIT_L(0); PG8_MMA(0, 0, At, B0); PG8_BAR; PG8_SCHED;
            PG8_LDB(B1, 0, 1); PG8_STAGE(PG8_SB(0, 0), b2, voffB);
            PG8_BAR; PG8_WAIT_L(0); PG8_MMA(0, 1, At, B1); PG8_BAR;
            PG8_LDA(At, 0, 1); PG8_STAGE(PG8_SA(0, 0), a2, voffA);
            PG8_BAR; PG8_WAIT_L(0); PG8_MMA(1, 0, At, B0); PG8_BAR; PG8_SCHED;
            PG8_STAGE(PG8_SB(0, 1), b2 + hstep, voffB);
            PG8_WAIT_V(6); PG8_BAR; PG8_MMA(1, 1, At, B1); PG8_BAR;
            PG8_LDB(B0, 1, 0); PG8_SCHED; PG8_LDA(At, 1, 0); PG8_STAGE(PG8_SA(0, 1), a2 + hstep, voffA);
            PG8_WAIT_L(8); PG8_BAR; PG8_WAIT_L(0); PG8_MMA(0, 0, At, B0); PG8_BAR; PG8_SCHED;
            PG8_LDB(B1, 1, 1); PG8_STAGE(PG8_SB(1, 0), b3, voffB);
            PG8_BAR; PG8_WAIT_L(0); PG8_MMA(0, 1, At, B1); PG8_BAR;
            PG8_LDA(At, 1, 1); PG8_STAGE(PG8_SA(1, 0), a3, voffA);
            PG8_BAR; PG8_WAIT_L(0); PG8_MMA(1, 0, At, B0); PG8_BAR; PG8_SCHED;
            PG8_STAGE(PG8_SB(1, 1), b3 + hstep, voffB);
            PG8_WAIT_V(6); PG8_BAR; PG8_MMA(1, 1, At, B1); PG8_BAR;
            }
        }
        if constexpr (ALIGN_EPI) { if (wr == 0) PG8_BAR; }
        if constexpr (!Epi::AFTER_DRAIN) { E(acc, cur, wr, wc, fr, fq); S.done(cur); }
        if (!has_next) break;
#pragma unroll
        for (int a = 0; a < 2; ++a)
#pragma unroll
            for (int b = 0; b < 2; ++b)
#pragma unroll
                for (int m = 0; m < 4; ++m)
#pragma unroll
                    for (int n = 0; n < 2; ++n) acc[a][b][m][n] = (f32x4){0.f, 0.f, 0.f, 0.f};
        cur = nxt; cA = nA; cB = nB; ++ui;
        if constexpr (ALIGN_EPI) { if (wr == 1) PG8_BAR; }
    }
    PG8_WAIT_V(0);
    if constexpr (!ALIGN_EPI) { if (wr == 0) PG8_BAR; }
    PG8_BAR;
    if constexpr (Epi::AFTER_DRAIN) { E.fused(acc, cur, wr, wc, fr, fq, lds, wid, lane); S.done(cur); }
#undef PG8_SA
#undef PG8_SB
#undef PG8_STAGE
#undef PG8_LDA
#undef PG8_LDB
#undef PG8_MMA
#undef PG8_WAIT_V
#undef PG8_WAIT_L
#undef PG8_BAR
#undef PG8_SCHED
}
}

#define GAS __attribute__((address_space(1)))
#define LAS __attribute__((address_space(3)))
typedef unsigned short bf16;
typedef unsigned v4u __attribute__((ext_vector_type(4)));
typedef float f32x4 __attribute__((ext_vector_type(4)));
typedef short bf16x8 __attribute__((ext_vector_type(8)));
typedef GAS unsigned gu32;
typedef GAS unsigned long long gu64;
#define RLX_AGENT __ATOMIC_RELAXED, __HIP_MEMORY_SCOPE_AGENT
#define LDS_WAIT() asm volatile("s_waitcnt lgkmcnt(0)" ::: "memory")
#define VM_WAIT() asm volatile("s_waitcnt vmcnt(0)" ::: "memory")
__device__ __forceinline__ unsigned long long rt() { return __builtin_amdgcn_s_memrealtime(); }
__device__ __forceinline__ unsigned f2bf(float f) { unsigned u = __builtin_bit_cast(unsigned, f); return (u + 0x7fffu + ((u >> 16) & 1u)) >> 16; }
__device__ __forceinline__ unsigned pk2(float lo, float hi) { return f2bf(lo) | (f2bf(hi) << 16); }
#define XB_TMO      128
#define XB_XCNT(j)  (256  + 64 * (j))
#define XB_XSUB(j)  (1280 + 64 * (j))
#define XB_XGEN(j)  (2304 + 64 * (j))
#define XB_TOP      3328
#define XB_TOPGEN   3392
#define XCD_BAR_WORDS 3456
#define XB_SPIN_CAP (1u << 18)

__device__ __forceinline__ unsigned xb_ld(unsigned* p)              { return __hip_atomic_load(p, __ATOMIC_RELAXED, __HIP_MEMORY_SCOPE_AGENT); }
__device__ __forceinline__ unsigned xb_add(unsigned* p, unsigned v) { return __hip_atomic_fetch_add(p, v, __ATOMIC_RELAXED, __HIP_MEMORY_SCOPE_AGENT); }
__device__ __forceinline__ unsigned xb_xcc_id() { return (unsigned)__builtin_amdgcn_s_getreg((3 << 11) | 20) & 0xFu; }
#define XB_SPIN(cond, bar) do { unsigned _sp = 0; while (cond) { __builtin_amdgcn_s_sleep(1); \
    if ((++_sp & 255u) == 0u) { if (xb_ld(&(bar)[XB_TMO])) break; if (_sp > XB_SPIN_CAP) { atomicAdd(&(bar)[XB_TMO], 1u); break; } } } } while (0)

struct XcdBarrier {
    unsigned* bar; unsigned x;
    volatile LAS unsigned* st;
};

__device__ __forceinline__ XcdBarrier xcd_barrier_post(unsigned* bar, volatile LAS unsigned* st) {
    XcdBarrier b; b.bar = bar; b.x = xb_xcc_id(); b.st = st;
    if (threadIdx.x == 0) (void)xb_add(&bar[XB_XCNT(b.x)], 1u);
    return b;
}
__device__ __forceinline__ void xcd_barrier_complete(unsigned* bar, unsigned x, unsigned& nloc, unsigned& nx) {
    const unsigned G = gridDim.x * gridDim.y * gridDim.z;
    unsigned sum, cnt, mine, sp = 0u;
    for (;;) {
        sum = 0u; cnt = 0u; mine = 0u;
#pragma unroll
        for (unsigned j = 0; j < 16; ++j) { const unsigned c = xb_ld(&bar[XB_XCNT(j)]); sum += c; cnt += (c > 0u) ? 1u : 0u; mine = (j == x) ? c : mine; }
        if (sum == G) break;
        __builtin_amdgcn_s_sleep(1);
        if ((++sp & 255u) == 0u) { if (xb_ld(&bar[XB_TMO])) break; if (sp > XB_SPIN_CAP) { atomicAdd(&bar[XB_TMO], 1u); break; } }
    }
    nloc = mine > 0u ? mine : 1u; nx = cnt > 0u ? cnt : 1u;
}

__device__ __forceinline__ void xcd_barrier(const XcdBarrier& b) {
    asm volatile("s_waitcnt vmcnt(0)" ::: "memory");
    __syncthreads();
    if (threadIdx.x == 0) {
        unsigned* bar = b.bar;
        __builtin_amdgcn_s_waitcnt(0);
        unsigned nloc = b.st[0], nx = b.st[1];
        if (nloc == 0u) { xcd_barrier_complete(bar, b.x, nloc, nx); b.st[0] = nloc; b.st[1] = nx; }
        const unsigned old = xb_add(&bar[XB_XSUB(b.x)], 1u);
        const unsigned gen = old / nloc;
        if (old + 1u == (gen + 1u) * nloc) {
            __builtin_amdgcn_fence(__ATOMIC_RELEASE, "agent");
            asm volatile("s_waitcnt vmcnt(0)" ::: "memory");
            const unsigned og = xb_add(&bar[XB_TOP], 1u);
            const unsigned tg = og / nx;
            if (og + 1u == (tg + 1u) * nx) xb_add(&bar[XB_TOPGEN], 1u);
            else XB_SPIN(xb_ld(&bar[XB_TOPGEN]) == tg, bar);
            __builtin_amdgcn_fence(__ATOMIC_ACQUIRE, "agent");
            xb_add(&bar[XB_XGEN(b.x)], 1u);
            asm volatile("s_waitcnt vmcnt(0)" ::: "memory");
        } else {
            XB_SPIN(xb_ld(&bar[XB_XGEN(b.x)]) == gen, bar);
            __builtin_amdgcn_fence(__ATOMIC_ACQUIRE, "agent");
            asm volatile("s_waitcnt vmcnt(0)" ::: "memory");
        }
    }
    __syncthreads();
}

constexpr int RING_OFF = 0, RING_BYTES = 131072;
constexpr int LDSCTL_OFF = RING_BYTES, MISC_OFF = LDSCTL_OFF + 320;
constexpr int LDS_BYTES = 147456;
constexpr size_t CTL_ZERO_BYTES = 64 * 1024;
constexpr int CW_BAR = 1024;

struct Params {
    const float *x, *c, *ctx, *c_ctx, *w_ada, *b_ada, *norm_g, *w_in, *conv_w, *conv_b, *gate_b, *sink, *head_g, *w_out, *final_g;
    float* out;
    unsigned* ctl;
    h16 *P, *XN, *CQK, *H, *WIN_T, *WOUT_T;
    float *XC, *GATES, *MOD;
};

__device__ __forceinline__ float silu_f(float x) { return x / (1.f + expf(-x)); }
__device__ __forceinline__ float sigmoid_f(float x) { return 1.f / (1.f + expf(-x)); }
__device__ __forceinline__ float wave_sum(float v) {
#pragma unroll
    for (int o = 1; o < 64; o <<= 1) v += __shfl_xor(v, o);
    return v;
}

__device__ __forceinline__ void transpose_item(const float* W, int K, int N, int Npad, h16* WT, LAS float* scr, int item, int lane) {
    const int nblk = Npad / 32, kb = item / nblk, nb = item % nblk, k0 = 64 * kb, n0 = 32 * nb;
#pragma unroll 8
    for (int i = 0; i < 32; ++i) { const int kk = 2 * i + (lane >> 5); const int n = n0 + (lane & 31); scr[kk * 33 + (lane & 31)] = n < N ? W[(size_t)(k0 + kk) * N + n] : 0.f; }
    LDS_WAIT(); asm volatile("" ::: "memory");
    const int c = lane & 7;
#pragma unroll
    for (int j = 0; j < 4; ++j) { const int n = (lane >> 3) + 8 * j; const LAS float* s = scr + (8 * c) * 33 + n;
        v4u o; o.x = pkh(s[0 * 33], s[1 * 33]); o.y = pkh(s[2 * 33], s[3 * 33]); o.z = pkh(s[4 * 33], s[5 * 33]); o.w = pkh(s[6 * 33], s[7 * 33]);
        *(GAS v4u*)(WT + (size_t)(n0 + n) * K + k0 + 8 * c) = o; }
    LDS_WAIT(); asm volatile("" ::: "memory");
}

__global__ void __launch_bounds__(NTHR, 2) fwd_megakernel(Params p) {
    extern __shared__ __attribute__((aligned(16))) unsigned char lds[];
    LAS unsigned char* ldsl = (LAS unsigned char*)lds;
    const int G = gridDim.x, bid = blockIdx.x, GT = G * NTHR, NGW = G * NWAVES;
#define PHASE_IDS() int tid = threadIdx.x; asm volatile("" : "+v"(tid)); const int lane = tid & 63, wave = __builtin_amdgcn_readfirstlane(tid >> 6); \
    const int gtid = bid * NTHR + tid, gw = bid * NWAVES + wave; (void)lane; (void)wave; (void)gtid; (void)gw
    for (int u = threadIdx.x; u < (LDS_BYTES - LDSCTL_OFF) / 4; u += NTHR) ((LAS unsigned*)(ldsl + LDSCTL_OFF))[u] = 0u;
    __syncthreads();
    volatile LAS unsigned* MISC = (volatile LAS unsigned*)(ldsl + MISC_OFF);
    XcdBarrier bar = xcd_barrier_post(p.ctl + CW_BAR, MISC + 8);
#define GRID_BAR() xcd_barrier(bar)

    {
        PHASE_IDS();
        LAS float* sc = (LAS float*)ldsl;
        LAS float* red = sc + 9 * 1024;
        for (int i = tid; i < 9 * 1024; i += NTHR) { const int r = i >> 10, k = i & 1023; const float v = (r < 8) ? p.c[r * 1024 + k] : p.c_ctx[k]; sc[i] = silu_f(v); }
        __syncthreads();
        for (int it = bid; it < DEPTH * 48; it += G) {
            const int l = it / 48, j = (it % 48) * 64 + lane;
            const float* w = p.w_ada + (size_t)l * 1024 * 3072 + j;
            float a0 = 0, a1 = 0, a2 = 0, a3 = 0, a4 = 0, a5 = 0, a6 = 0, a7 = 0, a8 = 0;
            for (int kk = 0; kk < 128; ++kk) { const int k = wave * 128 + kk; const float wv = w[(size_t)k * 3072];
                a0 += sc[0 * 1024 + k] * wv; a1 += sc[1 * 1024 + k] * wv; a2 += sc[2 * 1024 + k] * wv; a3 += sc[3 * 1024 + k] * wv; a4 += sc[4 * 1024 + k] * wv;
                a5 += sc[5 * 1024 + k] * wv; a6 += sc[6 * 1024 + k] * wv; a7 += sc[7 * 1024 + k] * wv; a8 += sc[8 * 1024 + k] * wv; }
            LAS float* rw = red + wave * 9 * 64 + lane;
            rw[0 * 64] = a0; rw[1 * 64] = a1; rw[2 * 64] = a2; rw[3 * 64] = a3; rw[4 * 64] = a4; rw[5 * 64] = a5; rw[6 * 64] = a6; rw[7 * 64] = a7; rw[8 * 64] = a8;
            __syncthreads();
            for (int e = tid; e < 9 * 64; e += NTHR) { float s = 0.f;
#pragma unroll
                for (int w8 = 0; w8 < 8; ++w8) s += red[w8 * 9 * 64 + e];
                const int r = e >> 6, jj = (it % 48) * 64 + (e & 63);
                p.MOD[((size_t)l * 9 + r) * 3072 + jj] = s + p.b_ada[l * 3072 + jj]; }
            __syncthreads();
        }
    }
    GRID_BAR();

    for (int l = 0; l < DEPTH; ++l) {
        const bool last = (l == DEPTH - 1);
        const float* MODl = p.MOD + (size_t)l * 9 * 3072;
        const float* xin_lat = (l == 0) ? p.x : p.out; const float* xin_ctx = (l == 0) ? p.ctx : p.XC;

        {
            PHASE_IDS();
            LAS float* scr = (LAS float*)(ldsl + wave * 16384);
            constexpr int I_IN = (D / 64) * (NPAD / 32), I_OUT = (D / 64) * (D / 32);
            for (int it = gw; it < I_IN + I_OUT; it += NGW) {
                if (it < I_IN) transpose_item(p.w_in + (size_t)l * D * INC, D, INC, NPAD, p.WIN_T, scr, it, lane);
                else transpose_item(p.w_out + (size_t)l * D * D, D, D, D, p.WOUT_T, scr, it - I_IN, lane);
            }
            const float* g = p.norm_g + l * D;
            for (int row = gw; row < NROW; row += NGW) {
                const float* xr = row < NLAT ? xin_lat + (size_t)row * D : xin_ctx + (size_t)(row - NLAT) * D;
                const int mr = row < NLAT ? (row >> 11) : 8;
                const float* shift = MODl + mr * 3072; const float* scale = shift + 1024;
                f32x4 v[4]; float ss = 0.f;
#pragma unroll
                for (int j = 0; j < 4; ++j) { v[j] = *(const f32x4*)(xr + (j * 64 + lane) * 4); ss += v[j].x * v[j].x + v[j].y * v[j].y + v[j].z * v[j].z + v[j].w * v[j].w; }
                ss = wave_sum(ss);
                const float rstd = 1.0f / sqrtf(ss * (1.f / D) + EPS);
#pragma unroll
                for (int j = 0; j < 4; ++j) { const int k = (j * 64 + lane) * 4;
                    const f32x4 gg = *(const f32x4*)(g + k), sc = *(const f32x4*)(scale + k), sh = *(const f32x4*)(shift + k);
                    const f32x4 o = v[j] * rstd * gg * (sc + 1.f) + sh;
                    uint2 w; w.x = pkh(o.x, o.y); w.y = pkh(o.z, o.w); *(uint2*)(p.XN + (size_t)row * D + k) = w; }
            }
        }
        GRID_BAR();

        {
            const pg8::bf16_t* gA = (const pg8::bf16_t*)p.XN; const pg8::bf16_t* gB = (const pg8::bf16_t*)p.WIN_T; asm volatile("" : "+s"(gA), "+s"(gB));
            pg8::Gemm g{gA, gB, NROW, NPAD, D}; pg8::StaticOrder S; S.init(NROW, NPAD, G, bid);
            pg8::EpiProjH E{p.P, p.GATES, p.gate_b + l * 16};
            pg8::gemm_phase<pg8::EpiProjH, pg8::StaticOrder, true, true>(ldsl + RING_OFF, g, S, E);
        }
        GRID_BAR();

        {
            PHASE_IDS();
            for (int idx = gtid; idx < NLAT * 320; idx += GT) {
                const int r = idx / 320, rem = idx % 320, hs = rem >> 5, hf = (rem >> 4) & 1, i = rem & 15;
                const int t = r & (T - 1);
                const int base = (hs < 8 ? hs * 64 : C_AK + (hs - 8) * 64) + hf * 32;
                h16* pp = p.P + (size_t)r * PW + base;
                const float a1 = (float)pp[i], a2 = (float)pp[16 + i];
                const float pos = (float)(hf == 0 ? (t >> 6) : (t & 63));
                const float inv = powf(10000.0f, -(float)i / 16.0f);
                const float ang = pos * inv; const float cs = cosf(ang), sn = sinf(ang);
                pp[i] = (h16)(a1 * cs - a2 * sn); pp[16 + i] = (h16)(a2 * cs + a1 * sn);
            }
            const float* cw = p.conv_w + (size_t)l * 5 * 1024; const float* cb = p.conv_b + l * 1024;
            for (int idx = gtid; idx < NROW * 1024; idx += GT) {
                const int r = idx >> 10, c = idx & 1023;
                int t, len; if (r < NLAT) { t = r & (T - 1); len = T; } else { t = (r - NLAT) & (LC - 1); len = LC; }
                float y = cb[c];
#pragma unroll
                for (int j = 0; j < 5; ++j) { const int tt = t + j - 2; if (tt >= 0 && tt < len) y += cw[j * 1024 + c] * (float)p.P[(size_t)(r + j - 2) * PW + C_MQ + c]; }
                p.CQK[(size_t)r * 1024 + c] = (h16)silu_f(y);
            }
        }
        GRID_BAR();

        {
            PHASE_IDS();
            const float* sink = p.sink + l * 8;
            const int nq = last ? NLAT * 8 : (NLAT + NCTX) * 8;
            for (int idx = gtid; idx < nq; idx += GT) {
                int hq, r, b, nwin, j0; bool isl = idx < NLAT * 8;
                if (isl) { hq = idx >> 14; r = idx & (NLAT - 1); b = r >> 11; const int t = r & (T - 1); j0 = t - 128 < 0 ? 0 : t - 128; const int j1 = t + 128 > T - 1 ? T - 1 : t + 128; nwin = j1 - j0 + 1; }
                else { const int i2 = idx - NLAT * 8; hq = i2 >> 11; const int rc = i2 & (NCTX - 1); r = NLAT + rc; b = rc >> 8; nwin = 0; j0 = 0; }
                const int hkv = hq >> 2;
                float q[64], o[64];
                { const h16* qp = p.P + (size_t)r * PW + C_AQ + hq * 64;
#pragma unroll
                  for (int d = 0; d < 64; ++d) { q[d] = (float)qp[d] * 0.125f; o[d] = 0.f; } }
                float m = sink[hq], lsum = 1.0f;
                for (int jj = 0; jj < nwin + LC; ++jj) {
                    const size_t kr = jj < nwin ? (size_t)(b * T + j0 + jj) : (size_t)(NLAT + b * LC + (jj - nwin));
                    const h16* kp = p.P + kr * PW + C_AK + hkv * 64; const h16* vp = p.P + kr * PW + C_AV + hkv * 64;
                    float s = 0.f;
#pragma unroll
                    for (int d = 0; d < 64; ++d) s += q[d] * (float)kp[d];
                    const float mn = fmaxf(m, s); const float f = expf(m - mn), pe = expf(s - mn);
                    lsum = lsum * f + pe; m = mn;
#pragma unroll
                    for (int d = 0; d < 64; ++d) o[d] = o[d] * f + pe * (float)vp[d];
                }
                const float il = 1.f / lsum; const h16* zp = p.P + (size_t)r * PW + C_AZ + hq * 64; h16* op = p.XN + (size_t)r * D + hq * 64;
#pragma unroll
                for (int d = 0; d < 64; ++d) op[d] = (h16)(o[d] * il * silu_f((float)zp[d]));
            }
            LAS float* sq = (LAS float*)ldsl; LAS float* sk = sq + 16 * 128; LAS float* sv = sk + 16 * 128; LAS float* sig = sv + 16 * 32; LAS float* sfg = sig + 16; LAS int* srow = (LAS int*)(sfg + 16);
            const int vl = tid >> 4, kg = tid & 15;
            for (int it = bid; it < NB * 4 * 4; it += G) {
                const int slice = it & 3, head = (it >> 2) & 3, b = it >> 4;
                for (int dir = 0; dir < 2; ++dir) {
                    float C[8], n[8]; float m = -INFINITY;
#pragma unroll
                    for (int i = 0; i < 8; ++i) { C[i] = 0.f; n[i] = 0.f; }
                    for (int p0 = 0; p0 < LC + T; p0 += 16) {
                        __syncthreads();
                        for (int e = tid; e < 16 * 128; e += NTHR) { const int s = e >> 7, d = e & 127; const int pp = p0 + s;
                            int row; if (pp < LC) { const int tc = dir == 0 ? pp : LC - 1 - pp; row = NLAT + b * LC + tc; } else { const int pl = pp - LC; const int tt = dir == 0 ? pl : T - 1 - pl; row = b * T + tt; }
                            sq[s * 128 + d] = (float)p.CQK[(size_t)row * 1024 + head * 128 + d];
                            sk[s * 128 + d] = (float)p.CQK[(size_t)row * 1024 + 512 + head * 128 + d] * 0.08838834764831845f;
                            if (d < 32) sv[s * 32 + d] = (float)p.P[(size_t)row * PW + C_MV + head * 128 + slice * 32 + d];
                            if (d == 0) { sig[s] = p.GATES[(size_t)row * 16 + dir * 4 + head]; sfg[s] = p.GATES[(size_t)row * 16 + 8 + dir * 4 + head]; srow[s] = row; } }
                        __syncthreads();
                        for (int s = 0; s < 16; ++s) {
                            const float fp = sfg[s], ip = sig[s];
                            const float lf = fminf(fp, 0.f) - log1pf(expf(-fabsf(fp)));
                            const float mn = fmaxf(lf + m, ip);
                            const float fs = expf(lf + m - mn), is_ = expf(ip - mn);
                            const float vv = sv[s * 32 + vl] * is_;
                            float num = 0.f, den = 0.f;
#pragma unroll
                            for (int i = 0; i < 8; ++i) { const float kk = sk[s * 128 + kg + 16 * i], qq = sq[s * 128 + kg + 16 * i];
                                C[i] = fs * C[i] + vv * kk; n[i] = fs * n[i] + is_ * kk; num += C[i] * qq; den += n[i] * qq; }
                            num += __shfl_xor(num, 1); num += __shfl_xor(num, 2); num += __shfl_xor(num, 4); num += __shfl_xor(num, 8);
                            den += __shfl_xor(den, 1); den += __shfl_xor(den, 2); den += __shfl_xor(den, 4); den += __shfl_xor(den, 8);
                            const float h = num / fmaxf(fabsf(den), expf(-mn));
                            m = mn;
                            if (kg == 0) { h16* hp = p.H + (size_t)srow[s] * 512 + head * 128 + slice * 32 + vl; if (dir == 0) *hp = (h16)h; else *hp = (h16)((float)*hp + h); }
                        }
                    }
                }
            }
            __syncthreads();
        }
        GRID_BAR();

        {
            PHASE_IDS();
            const float* hg = p.head_g + l * 512;
            const int nw = (last ? NLAT : NROW) * 4;
            for (int w = gw; w < nw; w += NGW) {
                const int r = w >> 2, head = w & 3; const int c0 = head * 128 + lane, c1 = c0 + 64;
                const float hs0 = (float)p.H[(size_t)r * 512 + c0], hs1 = (float)p.H[(size_t)r * 512 + c1];
                const float h0 = sigmoid_f((float)p.P[(size_t)r * PW + C_MO + c0]) * hs0;
                const float h1 = sigmoid_f((float)p.P[(size_t)r * PW + C_MO + c1]) * hs1;
                const float ms = wave_sum(h0 * h0 + h1 * h1) * (1.f / 128.f);
                const float rstd = 1.0f / sqrtf(ms + EPS);
                p.XN[(size_t)r * D + 512 + c0] = (h16)(h0 * rstd * hg[c0] * silu_f((float)p.P[(size_t)r * PW + C_MZ + c0]));
                p.XN[(size_t)r * D + 512 + c1] = (h16)(h1 * rstd * hg[c1] * silu_f((float)p.P[(size_t)r * PW + C_MZ + c1]));
            }
        }
        GRID_BAR();

        {
            const int M = last ? NLAT : NROW;
            const pg8::bf16_t* gA = (const pg8::bf16_t*)p.XN; const pg8::bf16_t* gB = (const pg8::bf16_t*)p.WOUT_T; asm volatile("" : "+s"(gA), "+s"(gB));
            pg8::Gemm g{gA, gB, M, D, D}; pg8::StaticOrder S; S.init(M, D, G, bid);
            pg8::EpiResF E{xin_lat, xin_ctx, p.out, p.XC, MODl};
            pg8::gemm_phase<pg8::EpiResF, pg8::StaticOrder, true, true>(ldsl + RING_OFF, g, S, E);
        }
        GRID_BAR();
    }

    {
        PHASE_IDS();
        const float* g = p.final_g;
        for (int row = gw; row < NLAT; row += NGW) {
            float* xr = p.out + (size_t)row * D;
            f32x4 v[4]; float ss = 0.f;
#pragma unroll
            for (int j = 0; j < 4; ++j) { v[j] = *(const f32x4*)(xr + (j * 64 + lane) * 4); ss += v[j].x * v[j].x + v[j].y * v[j].y + v[j].z * v[j].z + v[j].w * v[j].w; }
            ss = wave_sum(ss);
            const float rstd = 1.0f / sqrtf(ss * (1.f / D) + EPS);
#pragma unroll
            for (int j = 0; j < 4; ++j) { const int k = (j * 64 + lane) * 4; const f32x4 gg = *(const f32x4*)(g + k); *(f32x4*)(xr + k) = v[j] * rstd * gg; }
        }
    }
#undef GRID_BAR
}

extern "C" void kernel_launch(void* const* d_in, const int* in_sizes, int n_in, void* d_out, int out_size, void* d_ws, size_t ws_size, hipStream_t stream) {
    static int grid = 0;
    if (grid == 0) {
        int dev = 0, cus = 0, per_cu = 0;
        if (hipGetDevice(&dev) != hipSuccess || hipDeviceGetAttribute(&cus, hipDeviceAttributeMultiprocessorCount, dev) != hipSuccess) { fprintf(stderr, "kernel_launch: device query failed\n"); grid = -1; return; }
        if (hipFuncSetAttribute((const void*)fwd_megakernel, hipFuncAttributeMaxDynamicSharedMemorySize, LDS_BYTES) != hipSuccess) { fprintf(stderr, "kernel_launch: hipFuncSetAttribute failed\n"); grid = -1; return; }
        if (hipOccupancyMaxActiveBlocksPerMultiprocessor(&per_cu, (const void*)fwd_megakernel, NTHR, LDS_BYTES) != hipSuccess || per_cu < 1) { fprintf(stderr, "kernel_launch: occupancy query reports %d\n", per_cu); per_cu = 1; }
        (void)hipGetLastError();
        grid = cus;
        fprintf(stderr, "kernel_launch: cus %d per_cu %d grid %d\n", cus, per_cu, grid);
    }
    if (grid < 0) return;
    unsigned char* ws = (unsigned char*)d_ws; size_t off = 0;
    auto carve = [&](size_t bytes) { unsigned char* q = ws + off; off += (bytes + 255) & ~(size_t)255; return q; };
    Params p{};
    p.ctl = (unsigned*)carve(CTL_ZERO_BYTES);
    p.P = (h16*)carve((size_t)NROW * PW * 2);
    p.XN = (h16*)carve((size_t)NROW * D * 2);
    p.XC = (float*)carve((size_t)NCTX * D * 4);
    p.CQK = (h16*)carve((size_t)NROW * 1024 * 2);
    p.H = (h16*)carve((size_t)NROW * 512 * 2);
    p.GATES = (float*)carve((size_t)NROW * 16 * 4);
    p.MOD = (float*)carve((size_t)DEPTH * 9 * 3072 * 4);
    p.WIN_T = (h16*)carve((size_t)NPAD * D * 2);
    p.WOUT_T = (h16*)carve((size_t)D * D * 2);
    if (off > ws_size) { fprintf(stderr, "kernel_launch: workspace too small: need %zu have %zu\n", off, ws_size); return; }
    p.x = (const float*)d_in[0]; p.c = (const float*)d_in[1]; p.ctx = (const float*)d_in[2]; p.c_ctx = (const float*)d_in[3];
    p.w_ada = (const float*)d_in[4]; p.b_ada = (const float*)d_in[5]; p.norm_g = (const float*)d_in[6]; p.w_in = (const float*)d_in[7];
    p.conv_w = (const float*)d_in[8]; p.conv_b = (const float*)d_in[9]; p.gate_b = (const float*)d_in[10]; p.sink = (const float*)d_in[11];
    p.head_g = (const float*)d_in[12]; p.w_out = (const float*)d_in[13]; p.final_g = (const float*)d_in[14];
    p.out = (float*)d_out;
    if (hipMemsetAsync(p.ctl, 0, CTL_ZERO_BYTES, stream) != hipSuccess) { fprintf(stderr, "kernel_launch: memset failed\n"); return; }
    hipLaunchKernelGGL(fwd_megakernel, dim3(grid), dim3(NTHR), LDS_BYTES, stream, p);
}
```

```cpp
#include <hip/hip_runtime.h>
#include <cstdint>
#include <cstdio>

typedef _Float16 h16;

constexpr int NB = 8, T = 2048, D = 1024, DEPTH = 4, LC = 256;
constexpr int NLAT = NB * T, NCTX = NB * LC, NROW = NLAT + NCTX;
constexpr int INC = 3856, PW = 3840, NPAD = 4096;
constexpr int C_AQ = 0, C_AK = 512, C_AV = 640, C_AZ = 768, C_MQ = 1280, C_MK = 1792, C_MV = 2304, C_MO = 2816, C_MZ = 3328, C_MI = 3840;
constexpr float EPS = 1e-6f;
constexpr int NTHR = 512, NWAVES = 8;

typedef _Float16 h16x2 __attribute__((ext_vector_type(2)));
__device__ __forceinline__ unsigned pkh(float lo, float hi) { h16x2 v = {(h16)lo, (h16)hi}; return __builtin_bit_cast(unsigned, v); }

namespace pg8 {
#define PG8_LAS __attribute__((address_space(3)))
typedef unsigned short bf16_t;
typedef short bf16x8 __attribute__((ext_vector_type(8)));
typedef float f32x4 __attribute__((ext_vector_type(4)));
typedef unsigned u32x4 __attribute__((ext_vector_type(4)));
typedef _Float16 h16x8 __attribute__((ext_vector_type(8)));
constexpr int BM = 256, BK = 64, HALF = 128, HTB = HALF * BK * 2  , STAGE_BYTES = 8 * HTB, NXCD = 8, WGM = 8;

__host__ __device__ __forceinline__ int lds_byte(int r, int c) { const int st = (r >> 4) * 2 + (c >> 5), rr = r & 15, cc = c & 31, ob = rr * 64 + cc * 2; return st * 1024 + (ob ^ (((ob >> 9) & 1) << 5)); }
__host__ __device__ __forceinline__ void stage_rc(int b, int& R, int& C) { const int st = b / 1024, sb = b % 1024, swz = sb ^ (((sb >> 9) & 1) << 5); R = (st >> 1) * 16 + swz / 64; C = (st & 1) * 32 + (swz % 64) / 2; }
__host__ __device__ __forceinline__ int perm32(int rho) { const int n = rho >> 4, i = rho & 15; return 8 * (i >> 2) + 4 * n + (i & 3); }

struct Unit { int pm, pn; };
struct Gemm { const bf16_t* A; const bf16_t* Bt; int M, N, K; };

struct StaticOrder {
    int nM, nN, nwg, G, c;
    __host__ __device__ void init(int M, int N, int G_, int c_) { nM = M / BM; nN = N / BM; nwg = nM * nN; G = G_; c = c_; }
    __host__ __device__ bool next(int i, Unit& u) const {
        const long L = (long)i * G + c; if (L >= nwg) return false;
        int wgid = (int)L; { const int q = nwg / NXCD, r = nwg % NXCD, xcd = wgid % NXCD, off = wgid / NXCD; wgid = (xcd < r ? xcd * (q + 1) : r * (q + 1) + (xcd - r) * q) + off; }
        const int nig = WGM * nN, gid = wgid / nig, fm = gid * WGM, gsz = (nM - fm) < WGM ? (nM - fm) : WGM;
        u.pm = fm + ((wgid % nig) % gsz); u.pn = (wgid % nig) / gsz; return true;
    }
    __device__ __forceinline__ void a_ready(const Unit&) const {}
    __device__ __forceinline__ void done(const Unit&) const {}
};

struct EpiProjH {
    static constexpr bool PERM = true, AFTER_DRAIN = false;
    h16* P; float* GATES; const float* gate_b;
    __device__ __forceinline__ void operator()(const f32x4 (&acc)[2][2][4][2], const Unit& u, int wr, int wc, int fr, int fq) const {
        const int row0 = u.pm * BM + wr * 64 + fr;
        if (u.pn < 15) {
            const int col0 = u.pn * BM + wc * 32 + 8 * fq;
#pragma unroll
            for (int ai = 0; ai < 2; ++ai)
#pragma unroll
                for (int m = 0; m < 4; ++m) { h16* rowp = P + (size_t)(row0 + ai * HALF + m * 16) * PW + col0;
#pragma unroll
                    for (int bj = 0; bj < 2; ++bj) { const f32x4 v0 = acc[ai][bj][m][0], v1 = acc[ai][bj][m][1];
                        u32x4 w; w.x = pkh(v0[0], v0[1]); w.y = pkh(v0[2], v0[3]); w.z = pkh(v1[0], v1[1]); w.w = pkh(v1[2], v1[3]);
                        *(u32x4*)(rowp + bj * HALF) = w; } }
        } else if (wc == 0 && fq < 2) {
            const f32x4 b0 = *(const f32x4*)(gate_b + 8 * fq), b1 = *(const f32x4*)(gate_b + 8 * fq + 4);
#pragma unroll
            for (int ai = 0; ai < 2; ++ai)
#pragma unroll
                for (int m = 0; m < 4; ++m) { float* gp = GATES + (size_t)(row0 + ai * HALF + m * 16) * 16 + 8 * fq;
                    *(f32x4*)gp = acc[ai][0][m][0] + b0; *(f32x4*)(gp + 4) = acc[ai][0][m][1] + b1; }
        }
    }
};
struct EpiResF {
    static constexpr bool PERM = false, AFTER_DRAIN = false;
    const float* xin_lat; const float* xin_ctx; float* xout_lat; float* xout_ctx; const float* MODl;
    __device__ __forceinline__ void operator()(const f32x4 (&acc)[2][2][4][2], const Unit& u, int wr, int wc, int fr, int fq) const {
        const int row0 = u.pm * BM + wr * 64 + fr, col0 = u.pn * BM + wc * 32 + 4 * fq;
#pragma unroll
        for (int ai = 0; ai < 2; ++ai)
#pragma unroll
            for (int m = 0; m < 4; ++m) { const int r = row0 + ai * HALF + m * 16;
                const float* xi = r < NLAT ? xin_lat + (size_t)r * D : xin_ctx + (size_t)(r - NLAT) * D;
                float* xo = r < NLAT ? xout_lat + (size_t)r * D : xout_ctx + (size_t)(r - NLAT) * D;
                const float* gate = MODl + (r < NLAT ? (r >> 11) : 8) * 3072 + 2048;
#pragma unroll
                for (int bj = 0; bj < 2; ++bj)
#pragma unroll
                    for (int n = 0; n < 2; ++n) { const int c = col0 + bj * HALF + n * 16;
                        const f32x4 xv = *(const f32x4*)(xi + c), gv = *(const f32x4*)(gate + c);
                        *(f32x4*)(xo + c) = xv + gv * acc[ai][bj][m][n]; } }
    }
};

template <class Epi, class Sched, bool ALIGN_EPI = false, bool SP2 = false>
__device__ __forceinline__ void gemm_phase(PG8_LAS unsigned char* lds, const Gemm g, const Sched& S, const Epi& E) {
    int tid_l = threadIdx.x; asm volatile("" : "+v"(tid_l));
    const int tid = tid_l, wid = __builtin_amdgcn_readfirstlane(tid >> 6), lane = tid & 63, wr = wid >> 2, wc = wid & 3, fr = lane & 15, fq = lane >> 4;
    const int K = g.K, nt = K / BK;
    unsigned voffA[2], voffB[2];
#pragma unroll
    for (int i = 0; i < 2; ++i) { int R, C; stage_rc(tid * 16 + i * 8192, R, C); const int Rb = Epi::PERM ? ((R & ~31) + perm32(R & 31)) : R;
        voffA[i] = (unsigned)(R * K + C) * 2u; voffB[i] = (unsigned)(Rb * K + C) * 2u; }
    const size_t kstep = (size_t)(BK * 2);
    const size_t hstep = (size_t)HALF * K * 2;
    const size_t tstep = 2 * hstep;
    const unsigned ldsw = (unsigned)wid * 1024u;
    const int aoff = lds_byte(wr * 64 + fr, fq * 8), boff = lds_byte(wc * 32 + fr, fq * 8);
#define PG8_SA(b, h) (((b) * 2 + (h)) * HTB)
#define PG8_SB(b, h) ((4 + (b) * 2 + (h)) * HTB)
#define PG8_STAGE(bufoff, gbase, voff) do { _Pragma("unroll") for (int _i = 0; _i < 2; ++_i) \
        __builtin_amdgcn_global_load_lds((const unsigned*)((const char*)(gbase) + (voff)[_i]), (PG8_LAS unsigned*)(lds + (bufoff) + ldsw + _i * 8192), 16, 0, 0); } while (0)
#define PG8_LDA(dst, b, h) do { _Pragma("unroll") for (int m = 0; m < 4; ++m) _Pragma("unroll") for (int k = 0; k < 2; ++k) dst[m][k] = *(const PG8_LAS h16x8*)(lds + PG8_SA(b, h) + aoff + m * 2048 + k * 1024); } while (0)
#define PG8_LDB(dst, b, h) do { _Pragma("unroll") for (int n = 0; n < 2; ++n) _Pragma("unroll") for (int k = 0; k < 2; ++k) dst[n][k] = *(const PG8_LAS h16x8*)(lds + PG8_SB(b, h) + boff + n * 2048 + k * 1024); } while (0)
#define PG8_MMA(ai, bj, At, Bt) do { __builtin_amdgcn_s_setprio(1); _Pragma("unroll") for (int m = 0; m < 4; ++m) _Pragma("unroll") for (int n = 0; n < 2; ++n) _Pragma("unroll") for (int k = 0; k < 2; ++k) \
        acc[ai][bj][m][n] = __builtin_amdgcn_mfma_f32_16x16x32_f16(Bt[n][k], At[m][k], acc[ai][bj][m][n], 0, 0, 0); __builtin_amdgcn_s_setprio(0); } while (0)
#define PG8_WAIT_V(n) asm volatile("s_waitcnt vmcnt(" #n ")" ::: "memory")
#define PG8_WAIT_L(n) asm volatile("s_waitcnt lgkmcnt(" #n ")" ::: "memory")
#define PG8_BAR __builtin_amdgcn_s_barrier()
#define PG8_SCHED __builtin_amdgcn_sched_barrier(0)
    Unit cur, nxt; int ui = 0;
    if (!S.next(0, cur)) return;
    f32x4 acc[2][2][4][2];
#pragma unroll
    for (int a = 0; a < 2; ++a)
#pragma unroll
        for (int b = 0; b < 2; ++b)
#pragma unroll
            for (int m = 0; m < 4; ++m)
#pragma unroll
                for (int n = 0; n < 2; ++n) acc[a][b][m][n] = (f32x4){0.f, 0.f, 0.f, 0.f};
    h16x8 At[4][2], B0[2][2], B1[2][2];
    const char* cA = (const char*)g.A + (size_t)cur.pm * tstep; const char* cB = (const char*)g.Bt + (size_t)cur.pn * tstep;
    S.a_ready(cur);
    if constexpr (SP2) {
        PG8_STAGE(PG8_SB(0, 0), cB, voffB); PG8_STAGE(PG8_SB(0, 1), cB + hstep, voffB); PG8_STAGE(PG8_SA(0, 0), cA, voffA); PG8_STAGE(PG8_SA(0, 1), cA + hstep, voffA);
        if (wr == 1) PG8_BAR;
        PG8_WAIT_V(2); PG8_BAR;
        PG8_STAGE(PG8_SB(1, 0), cB + kstep, voffB); PG8_STAGE(PG8_SA(1, 0), cA + kstep, voffA); PG8_STAGE(PG8_SB(1, 1), cB + hstep + kstep, voffB);
        PG8_WAIT_V(6); PG8_BAR;
    } else {
        PG8_STAGE(PG8_SB(0, 0), cB, voffB); PG8_STAGE(PG8_SA(0, 0), cA, voffA); PG8_STAGE(PG8_SB(0, 1), cB + hstep, voffB); PG8_STAGE(PG8_SA(0, 1), cA + hstep, voffA);
        if (wr == 1) PG8_BAR;
        PG8_WAIT_V(4); PG8_BAR;
        PG8_STAGE(PG8_SB(1, 0), cB + kstep, voffB); PG8_STAGE(PG8_SA(1, 0), cA + kstep, voffA); PG8_STAGE(PG8_SB(1, 1), cB + hstep + kstep, voffB);
        PG8_WAIT_V(6); PG8_BAR;
    }
    for (;;) {
        const bool has_next = S.next(ui + 1, nxt);
        const char* nA = has_next ? (const char*)g.A + (size_t)nxt.pm * tstep : cA; const char* nB = has_next ? (const char*)g.Bt + (size_t)nxt.pn * tstep : cB;
        for (int t = 0; t < nt; t += 2) {
            const bool last = (t == nt - 2);
            const char* a1 = cA + (size_t)(t + 1) * kstep;
            const char* a2 = last ? nA : cA + (size_t)(t + 2) * kstep; const char* b2 = last ? nB : cB + (size_t)(t + 2) * kstep;
            const char* a3 = a2 + kstep; const char* b3 = b2 + kstep;
            if (last && has_next) S.a_ready(nxt);
            if constexpr (SP2) {
            PG8_LDB(B0, 0, 0); PG8_LDB(B1, 0, 1); PG8_SCHED; PG8_LDA(At, 0, 0); PG8_STAGE(PG8_SA(1, 1), a1 + hstep, voffA);
            PG8_WAIT_V(8); PG8_WAIT_L(0); PG8_BAR; PG8_MMA(0, 0, At, B0); PG8_MMA(0, 1, At, B1); PG8_BAR; PG8_SCHED;
            PG8_LDA(At, 0, 1); PG8_STAGE(PG8_SB(0, 0), b2, voffB); PG8_STAGE(PG8_SB(0, 1), b2 + hstep, voffB); PG8_STAGE(PG8_SA(0, 0), a2, voffA);
            PG8_WAIT_V(8); PG8_WAIT_L(0); PG8_BAR; PG8_MMA(1, 0, At, B0); PG8_MMA(1, 1, At, B1); PG8_BAR; PG8_SCHED;
            PG8_LDB(B0, 1, 0); PG8_LDB(B1, 1, 1); PG8_SCHED; PG8_LDA(At, 1, 0); PG8_STAGE(PG8_SA(0, 1), a2 + hstep, voffA);
            PG8_WAIT_V(8); PG8_WAIT_L(0); PG8_BAR; PG8_MMA(0, 0, At, B0); PG8_MMA(0, 1, At, B1); PG8_BAR; PG8_SCHED;
            PG8_LDA(At, 1, 1); PG8_STAGE(PG8_SB(1, 0), b3, voffB); PG8_STAGE(PG8_SB(1, 1), b3 + hstep, voffB); PG8_STAGE(PG8_SA(1, 0), a3, voffA);
            PG8_WAIT_V(8); PG8_WAIT_L(0); PG8_BAR; PG8_MMA(1, 0, At, B0); PG8_MMA(1, 1, At, B1); PG8_BAR; PG8_SCHED;
            } else {
            PG8_LDB(B0, 0, 0); PG8_SCHED; PG8_LDA(At, 0, 0); PG8_STAGE(PG8_SA(1, 1), a1 + hstep, voffA);
            PG8_WAIT_L(8); PG8_BAR; PG8_WAIT_L(0); PG8_MMA(0, 0, At, B0); PG8_BAR; PG8_SCHED;
            PG8_LDB(B1, 0, 1); PG8_STAGE(PG8_SB(0, 0), b2, voffB);
            PG8_BAR; PG8_WAIT_L(0); PG8_MMA(0, 1, At, B1); PG8_BAR;
            PG8_LDA(At, 0, 1); PG8_STAGE(PG8_SA(0, 0), a2, voffA);
            PG8_BAR; PG8_WAIT_L(0); PG8_MMA(1, 0, At, B0); PG8_BAR; PG8_SCHED;
            PG8_STAGE(PG8_SB(0, 1), b2 + hstep, voffB);
            PG8_WAIT_V(6); PG8_BAR; PG8_MMA(1, 1, At, B1); PG8_BAR;
            PG8_LDB(B0, 1, 0); PG8_SCHED; PG8_LDA(At, 1, 0); PG8_STAGE(PG8_SA(0, 1), a2 + hstep, voffA);
            PG8_WAIT_L(8); PG8_BAR; PG8_WAIT_L(0); PG8_MMA(0, 0, At, B0); PG8_BAR; PG8_SCHED;
            PG8_LDB(B1, 1, 1); PG8_STAGE(PG8_SB(1, 0), b3, voffB);
            PG8_BAR; PG8_WAIT_L(0); PG8_MMA(0, 1, At, B1); PG8_BAR;
            PG8_LDA(At, 1, 1); PG8_STAGE(PG8_SA(1, 0), a3, voffA);
            PG8_BAR; PG8_WAIT_L(0); PG8_MMA(1, 0, At, B0); PG8_BAR; PG8_SCHED;
            PG8_STAGE(PG8_SB(1, 1), b3 + hstep, voffB);
            PG8_WAIT_V(6); PG8_BAR; PG8_MMA(1, 1, At, B1); PG8_BAR;
            }
        }
        if constexpr (ALIGN_EPI) { if (wr == 0) PG8_BAR; }
        if constexpr (!Epi::AFTER_DRAIN) { E(acc, cur, wr, wc, fr, fq); S.done(cur); }
        if (!has_next) break;
#pragma unroll
        for (int a = 0; a < 2; ++a)
#pragma unroll
            for (int b = 0; b < 2; ++b)
#pragma unroll
                for (int m = 0; m < 4; ++m)
#pragma unroll
                    for (int n = 0; n < 2; ++n) acc[a][b][m][n] = (f32x4){0.f, 0.f, 0.f, 0.f};
        cur = nxt; cA = nA; cB = nB; ++ui;
        if constexpr (ALIGN_EPI) { if (wr == 1) PG8_BAR; }
    }
    PG8_WAIT_V(0);
    if constexpr (!ALIGN_EPI) { if (wr == 0) PG8_BAR; }
    PG8_BAR;
    if constexpr (Epi::AFTER_DRAIN) { E.fused(acc, cur, wr, wc, fr, fq, lds, wid, lane); S.done(cur); }
#undef PG8_SA
#undef PG8_SB
#undef PG8_STAGE
#undef PG8_LDA
#undef PG8_LDB
#undef PG8_MMA
#undef PG8_WAIT_V
#undef PG8_WAIT_L
#undef PG8_BAR
#undef PG8_SCHED
}
}

#define GAS __attribute__((address_space(1)))
#define LAS __attribute__((address_space(3)))
typedef unsigned short bf16;
typedef unsigned v4u __attribute__((ext_vector_type(4)));
typedef float f32x4 __attribute__((ext_vector_type(4)));
typedef short bf16x8 __attribute__((ext_vector_type(8)));
typedef GAS unsigned gu32;
typedef GAS unsigned long long gu64;
#define RLX_AGENT __ATOMIC_RELAXED, __HIP_MEMORY_SCOPE_AGENT
#define LDS_WAIT() asm volatile("s_waitcnt lgkmcnt(0)" ::: "memory")
#define VM_WAIT() asm volatile("s_waitcnt vmcnt(0)" ::: "memory")
__device__ __forceinline__ unsigned long long rt() { return __builtin_amdgcn_s_memrealtime(); }
__device__ __forceinline__ unsigned f2bf(float f) { unsigned u = __builtin_bit_cast(unsigned, f); return (u + 0x7fffu + ((u >> 16) & 1u)) >> 16; }
__device__ __forceinline__ unsigned pk2(float lo, float hi) { return f2bf(lo) | (f2bf(hi) << 16); }
#define XB_TMO      128
#define XB_XCNT(j)  (256  + 64 * (j))
#define XB_XSUB(j)  (1280 + 64 * (j))
#define XB_XGEN(j)  (2304 + 64 * (j))
#define XB_TOP      3328
#define XB_TOPGEN   3392
#define XCD_BAR_WORDS 3456
#define XB_SPIN_CAP (1u << 18)

__device__ __forceinline__ unsigned xb_ld(unsigned* p)              { return __hip_atomic_load(p, __ATOMIC_RELAXED, __HIP_MEMORY_SCOPE_AGENT); }
__device__ __forceinline__ unsigned xb_add(unsigned* p, unsigned v) { return __hip_atomic_fetch_add(p, v, __ATOMIC_RELAXED, __HIP_MEMORY_SCOPE_AGENT); }
__device__ __forceinline__ unsigned xb_xcc_id() { return (unsigned)__builtin_amdgcn_s_getreg((3 << 11) | 20) & 0xFu; }
#define XB_SPIN(cond, bar) do { unsigned _sp = 0; while (cond) { __builtin_amdgcn_s_sleep(1); \
    if ((++_sp & 255u) == 0u) { if (xb_ld(&(bar)[XB_TMO])) break; if (_sp > XB_SPIN_CAP) { atomicAdd(&(bar)[XB_TMO], 1u); break; } } } } while (0)

struct XcdBarrier {
    unsigned* bar; unsigned x;
    volatile LAS unsigned* st;
};

__device__ __forceinline__ XcdBarrier xcd_barrier_post(unsigned* bar, volatile LAS unsigned* st) {
    XcdBarrier b; b.bar = bar; b.x = (unsigned)__builtin_amdgcn_readfirstlane((int)xb_xcc_id()); b.st = st;
    if (threadIdx.x == 0) (void)xb_add(&bar[XB_XCNT(b.x)], 1u);
    return b;
}
__device__ __forceinline__ void xcd_barrier_complete(unsigned* bar, unsigned x, unsigned& nloc, unsigned& nx) {
    const unsigned G = gridDim.x * gridDim.y * gridDim.z;
    unsigned sum, cnt, mine, sp = 0u;
    for (;;) {
        sum = 0u; cnt = 0u; mine = 0u;
#pragma unroll
        for (unsigned j = 0; j < 16; ++j) { const unsigned c = xb_ld(&bar[XB_XCNT(j)]); sum += c; cnt += (c > 0u) ? 1u : 0u; mine = (j == x) ? c : mine; }
        if (sum == G) break;
        __builtin_amdgcn_s_sleep(1);
        if ((++sp & 255u) == 0u) { if (xb_ld(&bar[XB_TMO])) break; if (sp > XB_SPIN_CAP) { atomicAdd(&bar[XB_TMO], 1u); break; } }
    }
    nloc = mine > 0u ? mine : 1u; nx = cnt > 0u ? cnt : 1u;
}

__device__ __forceinline__ void xcd_barrier(const XcdBarrier& b) {
    asm volatile("s_waitcnt vmcnt(0)" ::: "memory");
    __syncthreads();
    if (threadIdx.x == 0) {
        unsigned* bar = b.bar;
        __builtin_amdgcn_s_waitcnt(0);
        unsigned nloc = b.st[0], nx = b.st[1];
        if (nloc == 0u) { xcd_barrier_complete(bar, b.x, nloc, nx); b.st[0] = nloc; b.st[1] = nx; }
        const unsigned old = xb_add(&bar[XB_XSUB(b.x)], 1u);
        const unsigned gen = old / nloc;
        if (old + 1u == (gen + 1u) * nloc) {
            __builtin_amdgcn_fence(__ATOMIC_RELEASE, "agent");
            asm volatile("s_waitcnt vmcnt(0)" ::: "memory");
            const unsigned og = xb_add(&bar[XB_TOP], 1u);
            const unsigned tg = og / nx;
            if (og + 1u == (tg + 1u) * nx) xb_add(&bar[XB_TOPGEN], 1u);
            else XB_SPIN(xb_ld(&bar[XB_TOPGEN]) == tg, bar);
            __builtin_amdgcn_fence(__ATOMIC_ACQUIRE, "agent");
            xb_add(&bar[XB_XGEN(b.x)], 1u);
            asm volatile("s_waitcnt vmcnt(0)" ::: "memory");
        } else {
            XB_SPIN(xb_ld(&bar[XB_XGEN(b.x)]) == gen, bar);
            __builtin_amdgcn_fence(__ATOMIC_ACQUIRE, "agent");
            asm volatile("s_waitcnt vmcnt(0)" ::: "memory");
        }
    }
    __syncthreads();
}

constexpr int RING_OFF = 0, RING_BYTES = 131072;
constexpr int LDSCTL_OFF = RING_BYTES, MISC_OFF = LDSCTL_OFF + 320;
constexpr int LDS_BYTES = 147456;
constexpr size_t CTL_ZERO_BYTES = 64 * 1024;
constexpr int CW_BAR = 1024;

struct Params {
    const float *x, *c, *ctx, *c_ctx, *w_ada, *b_ada, *norm_g, *w_in, *conv_w, *conv_b, *gate_b, *sink, *head_g, *w_out, *final_g;
    float* out;
    unsigned* ctl;
    h16 *P, *XN, *CQK, *H, *WIN_T, *WOUT_T;
    float *XC, *GATES, *MOD;
};

__device__ __forceinline__ float silu_f(float x) { return x / (1.f + expf(-x)); }
__device__ __forceinline__ float sigmoid_f(float x) { return 1.f / (1.f + expf(-x)); }
__device__ __forceinline__ float wave_sum(float v) {
#pragma unroll
    for (int o = 1; o < 64; o <<= 1) v += __shfl_xor(v, o);
    return v;
}

__device__ __forceinline__ void transpose_item(const float* W, int K, int N, int Npad, h16* WT, LAS float* scr, int item, int lane) {
    const int nblk = Npad / 32, kb = item / nblk, nb = item % nblk, k0 = 64 * kb, n0 = 32 * nb;
#pragma unroll 8
    for (int i = 0; i < 32; ++i) { const int kk = 2 * i + (lane >> 5); const int n = n0 + (lane & 31); scr[kk * 33 + (lane & 31)] = n < N ? W[(size_t)(k0 + kk) * N + n] : 0.f; }
    LDS_WAIT(); asm volatile("" ::: "memory");
    const int c = lane & 7;
#pragma unroll
    for (int j = 0; j < 4; ++j) { const int n = (lane >> 3) + 8 * j; const LAS float* s = scr + (8 * c) * 33 + n;
        v4u o; o.x = pkh(s[0 * 33], s[1 * 33]); o.y = pkh(s[2 * 33], s[3 * 33]); o.z = pkh(s[4 * 33], s[5 * 33]); o.w = pkh(s[6 * 33], s[7 * 33]);
        *(GAS v4u*)(WT + (size_t)(n0 + n) * K + k0 + 8 * c) = o; }
    LDS_WAIT(); asm volatile("" ::: "memory");
}


typedef short v4i16_t __attribute__((ext_vector_type(4)));
typedef _Float16 h16x4 __attribute__((ext_vector_type(4)));
typedef _Float16 h16x8 __attribute__((ext_vector_type(8)));
constexpr int AT_RB = 128, AT_TILE = 64 * AT_RB;
constexpr float AT_SC = 0.18033688011112042f, LOG2E = 1.4426950408889634f;
__device__ __forceinline__ h16x4 tr16(LAS unsigned char* p) { return __builtin_bit_cast(h16x4, __builtin_amdgcn_ds_read_tr16_b64_v4i16((LAS v4i16_t*)p)); }
__device__ __forceinline__ void attn_phase(LAS unsigned char* lds, const h16* __restrict__ P, const float* __restrict__ sink, h16* __restrict__ MIX, int bid, int G, int nitems) {
    int tid = threadIdx.x; asm volatile("" : "+v"(tid));
    const int lane = tid & 63, wave = __builtin_amdgcn_readfirstlane(tid >> 6), l15 = lane & 15, g = lane >> 4;
    const int srow = tid >> 3, sseg = tid & 7;
    for (int it = bid; it < nitems; it += G) {
        int b, hkv, n, qrow0, nch; bool isctx;
        if (it < 256) { b = it >> 5; hkv = (it >> 4) & 1; n = it & 15; qrow0 = b * T + n * 128; nch = (n == 0 || n == 15) ? 8 : 10; isctx = false; }
        else { const int j = it - 256; b = j >> 2; hkv = (j >> 1) & 1; n = j & 1; qrow0 = NLAT + b * LC + n * 128; nch = 4; isctx = true; }
        const int hq = hkv * 4 + (wave >> 1), iq0 = (wave & 1) * 64;
#define AT_CI(k) (isctx ? (k) + 6 : (k) + ((n == 0 || (n == 15 && (k) >= 4)) ? 2 : 0))
#define AT_ROW(ci) ((ci) < 6 ? b * T + (n - 1) * 128 + (ci) * 64 : NLAT + b * LC + ((ci) - 6) * 64)
        h16x8 qf[4][2];
#pragma unroll
        for (int qt = 0; qt < 4; ++qt) { const h16* qp = P + (size_t)(qrow0 + iq0 + qt * 16 + l15) * PW + C_AQ + hq * 64 + g * 8; qf[qt][0] = *(const h16x8*)qp; qf[qt][1] = *(const h16x8*)(qp + 32); }
        float m[4], lsum[4]; f32x4 O[4][4];
        const float sinkv = sink[hq] * LOG2E;
#pragma unroll
        for (int qt = 0; qt < 4; ++qt) { m[qt] = sinkv; lsum[qt] = (g == 0) ? 1.f : 0.f;
#pragma unroll
            for (int dt = 0; dt < 4; ++dt) O[dt][qt] = (f32x4){0.f, 0.f, 0.f, 0.f}; }
        const int sswz = (sseg ^ ((srow >> 1) & 7)) * 8;
#define AT_STAGE(ci_, buf_) do { const size_t r_ = (size_t)(AT_ROW(ci_) + srow); \
            __builtin_amdgcn_global_load_lds((const unsigned*)(P + r_ * PW + C_AK + hkv * 64 + sswz), (LAS unsigned*)(lds + (buf_) * AT_TILE + wave * 1024), 16, 0, 0); \
            __builtin_amdgcn_global_load_lds((const unsigned*)(P + r_ * PW + C_AV + hkv * 64 + sswz), (LAS unsigned*)(lds + (2 + (buf_)) * AT_TILE + wave * 1024), 16, 0, 0); } while (0)
        { const int ci0 = AT_CI(0); AT_STAGE(ci0, 0); }
        __syncthreads();
        for (int k = 0; k < nch; ++k) {
            const int cur = k & 1, ci = AT_CI(k);
            if (k + 1 < nch) { const int c2 = AT_CI(k + 1); AT_STAGE(c2, cur ^ 1); }
            LAS unsigned char* Kb = lds + cur * AT_TILE; LAS unsigned char* Vb = lds + (2 + cur) * AT_TILE;
            const int mtype = (ci < 2) ? 1 : ((ci == 4 || ci == 5) ? 2 : 0);
#pragma unroll 1
            for (int sub = 0; sub < 2; ++sub) {
                f32x4 s[2][4];
#pragma unroll
                for (int t = 0; t < 2; ++t) { const int kr = sub * 32 + t * 16 + l15, ksw = (kr >> 1) & 7; const LAS unsigned char* kp = Kb + kr * AT_RB;
                    const h16x8 kf0 = *(const LAS h16x8*)(kp + ((g ^ ksw) << 4)), kf1 = *(const LAS h16x8*)(kp + (((4 + g) ^ ksw) << 4));
#pragma unroll
                    for (int qt = 0; qt < 4; ++qt) { f32x4 z = (f32x4){0.f, 0.f, 0.f, 0.f}; z = __builtin_amdgcn_mfma_f32_16x16x32_f16(kf0, qf[qt][0], z, 0, 0, 0); s[t][qt] = __builtin_amdgcn_mfma_f32_16x16x32_f16(kf1, qf[qt][1], z, 0, 0, 0); } }
#pragma unroll
                for (int t = 0; t < 2; ++t)
#pragma unroll
                    for (int qt = 0; qt < 4; ++qt)
#pragma unroll
                        for (int r = 0; r < 4; ++r) { float v = s[t][qt][r] * AT_SC;
                            if (mtype) { const int jk = ci * 64 + sub * 32 + t * 16 + 4 * g + r, iq = iq0 + qt * 16 + l15; const bool ok = (mtype == 1) ? (jk >= iq) : (jk <= iq + 256); v = ok ? v : -INFINITY; }
                            s[t][qt][r] = v; }
                h16x8 pb[4];
#pragma unroll
                for (int qt = 0; qt < 4; ++qt) {
                    float mx = fmaxf(fmaxf(fmaxf(s[0][qt][0], s[0][qt][1]), fmaxf(s[0][qt][2], s[0][qt][3])), fmaxf(fmaxf(s[1][qt][0], s[1][qt][1]), fmaxf(s[1][qt][2], s[1][qt][3])));
                    mx = fmaxf(mx, __shfl_xor(mx, 16)); mx = fmaxf(mx, __shfl_xor(mx, 32));
                    const float mn = fmaxf(m[qt], mx); const float f = __builtin_amdgcn_exp2f(m[qt] - mn); m[qt] = mn;
                    float ps = 0.f;
#pragma unroll
                    for (int t = 0; t < 2; ++t)
#pragma unroll
                        for (int r = 0; r < 4; ++r) { const float pe = __builtin_amdgcn_exp2f(s[t][qt][r] - mn); s[t][qt][r] = pe; ps += pe; }
                    lsum[qt] = lsum[qt] * f + ps;
#pragma unroll
                    for (int dt = 0; dt < 4; ++dt) O[dt][qt] = O[dt][qt] * f;
                    pb[qt] = (h16x8){(h16)s[0][qt][0], (h16)s[0][qt][1], (h16)s[0][qt][2], (h16)s[0][qt][3], (h16)s[1][qt][0], (h16)s[1][qt][1], (h16)s[1][qt][2], (h16)s[1][qt][3]};
                }
#pragma unroll
                for (int dt = 0; dt < 4; ++dt) { const int vr = sub * 32 + 4 * g + (l15 >> 2), vsw = (vr >> 1) & 7, vc = 2 * dt + ((l15 >> 1) & 1);
                    LAS unsigned char* vp = Vb + vr * AT_RB + ((vc ^ vsw) << 4) + (l15 & 1) * 8;
                    const h16x4 lo = tr16(vp), hi = tr16(vp + 16 * AT_RB);
                    const h16x8 va = __builtin_shufflevector(lo, hi, 0, 1, 2, 3, 4, 5, 6, 7);
#pragma unroll
                    for (int qt = 0; qt < 4; ++qt) O[dt][qt] = __builtin_amdgcn_mfma_f32_16x16x32_f16(va, pb[qt], O[dt][qt], 0, 0, 0); }
            }
            __syncthreads();
        }
#pragma unroll
        for (int qt = 0; qt < 4; ++qt) { float lt = lsum[qt]; lt += __shfl_xor(lt, 16); lt += __shfl_xor(lt, 32); const float inv = 1.f / lt;
            const size_t qrow = (size_t)(qrow0 + iq0 + qt * 16 + l15);
#pragma unroll
            for (int dt = 0; dt < 4; ++dt) { const int d0 = dt * 16 + 4 * g;
                const h16x4 az = *(const h16x4*)(P + qrow * PW + C_AZ + hq * 64 + d0);
                const f32x4 o = O[dt][qt] * inv;
                uint2 w; w.x = pkh(o[0] * silu_f((float)az[0]), o[1] * silu_f((float)az[1])); w.y = pkh(o[2] * silu_f((float)az[2]), o[3] * silu_f((float)az[3]));
                *(uint2*)(MIX + qrow * D + hq * 64 + d0) = w; } }
#undef AT_CI
#undef AT_ROW
#undef AT_STAGE
    }
}

__global__ void __launch_bounds__(NTHR, 2) fwd_megakernel(Params p) {
    extern __shared__ __attribute__((aligned(16))) unsigned char lds[];
    LAS unsigned char* ldsl = (LAS unsigned char*)lds;
    const int G = gridDim.x, bid = blockIdx.x, GT = G * NTHR, NGW = G * NWAVES;
#define PHASE_IDS() int tid = threadIdx.x; asm volatile("" : "+v"(tid)); const int lane = tid & 63, wave = __builtin_amdgcn_readfirstlane(tid >> 6); \
    const int gtid = bid * NTHR + tid, gw = bid * NWAVES + wave; (void)lane; (void)wave; (void)gtid; (void)gw
    for (int u = threadIdx.x; u < (LDS_BYTES - LDSCTL_OFF) / 4; u += NTHR) ((LAS unsigned*)(ldsl + LDSCTL_OFF))[u] = 0u;
    __syncthreads();
    volatile LAS unsigned* MISC = (volatile LAS unsigned*)(ldsl + MISC_OFF);
    XcdBarrier bar = xcd_barrier_post(p.ctl + CW_BAR, MISC + 8);
#define GRID_BAR() xcd_barrier(bar)

    {
        PHASE_IDS();
        LAS float* sc = (LAS float*)ldsl;
        LAS float* red = sc + 9 * 1024;
        for (int i = tid; i < 9 * 1024; i += NTHR) { const int r = i >> 10, k = i & 1023; const float v = (r < 8) ? p.c[r * 1024 + k] : p.c_ctx[k]; sc[i] = silu_f(v); }
        __syncthreads();
        for (int it = bid; it < DEPTH * 48; it += G) {
            const int l = it / 48, j = (it % 48) * 64 + lane;
            const float* w = p.w_ada + (size_t)l * 1024 * 3072 + j;
            float a0 = 0, a1 = 0, a2 = 0, a3 = 0, a4 = 0, a5 = 0, a6 = 0, a7 = 0, a8 = 0;
            for (int kk = 0; kk < 128; ++kk) { const int k = wave * 128 + kk; const float wv = w[(size_t)k * 3072];
                a0 += sc[0 * 1024 + k] * wv; a1 += sc[1 * 1024 + k] * wv; a2 += sc[2 * 1024 + k] * wv; a3 += sc[3 * 1024 + k] * wv; a4 += sc[4 * 1024 + k] * wv;
                a5 += sc[5 * 1024 + k] * wv; a6 += sc[6 * 1024 + k] * wv; a7 += sc[7 * 1024 + k] * wv; a8 += sc[8 * 1024 + k] * wv; }
            LAS float* rw = red + wave * 9 * 64 + lane;
            rw[0 * 64] = a0; rw[1 * 64] = a1; rw[2 * 64] = a2; rw[3 * 64] = a3; rw[4 * 64] = a4; rw[5 * 64] = a5; rw[6 * 64] = a6; rw[7 * 64] = a7; rw[8 * 64] = a8;
            __syncthreads();
            for (int e = tid; e < 9 * 64; e += NTHR) { float s = 0.f;
#pragma unroll
                for (int w8 = 0; w8 < 8; ++w8) s += red[w8 * 9 * 64 + e];
                const int r = e >> 6, jj = (it % 48) * 64 + (e & 63);
                p.MOD[((size_t)l * 9 + r) * 3072 + jj] = s + p.b_ada[l * 3072 + jj]; }
            __syncthreads();
        }
    }
    GRID_BAR();

    for (int l = 0; l < DEPTH; ++l) {
        const bool last = (l == DEPTH - 1);
        const float* MODl = p.MOD + (size_t)l * 9 * 3072;
        const float* xin_lat = (l == 0) ? p.x : p.out; const float* xin_ctx = (l == 0) ? p.ctx : p.XC;

        {
            PHASE_IDS();
            LAS float* scr = (LAS float*)(ldsl + wave * 16384);
            constexpr int I_IN = (D / 64) * (NPAD / 32), I_OUT = (D / 64) * (D / 32);
            for (int it = gw; it < I_IN + I_OUT; it += NGW) {
                if (it < I_IN) transpose_item(p.w_in + (size_t)l * D * INC, D, INC, NPAD, p.WIN_T, scr, it, lane);
                else transpose_item(p.w_out + (size_t)l * D * D, D, D, D, p.WOUT_T, scr, it - I_IN, lane);
            }
            const float* g = p.norm_g + l * D;
            for (int row = gw; row < NROW; row += NGW) {
                const float* xr = row < NLAT ? xin_lat + (size_t)row * D : xin_ctx + (size_t)(row - NLAT) * D;
                const int mr = row < NLAT ? (row >> 11) : 8;
                const float* shift = MODl + mr * 3072; const float* scale = shift + 1024;
                f32x4 v[4]; float ss = 0.f;
#pragma unroll
                for (int j = 0; j < 4; ++j) { v[j] = *(const f32x4*)(xr + (j * 64 + lane) * 4); ss += v[j].x * v[j].x + v[j].y * v[j].y + v[j].z * v[j].z + v[j].w * v[j].w; }
                ss = wave_sum(ss);
                const float rstd = 1.0f / sqrtf(ss * (1.f / D) + EPS);
#pragma unroll
                for (int j = 0; j < 4; ++j) { const int k = (j * 64 + lane) * 4;
                    const f32x4 gg = *(const f32x4*)(g + k), sc = *(const f32x4*)(scale + k), sh = *(const f32x4*)(shift + k);
                    const f32x4 o = v[j] * rstd * gg * (sc + 1.f) + sh;
                    uint2 w; w.x = pkh(o.x, o.y); w.y = pkh(o.z, o.w); *(uint2*)(p.XN + (size_t)row * D + k) = w; }
            }
        }
        GRID_BAR();

        {
            const pg8::bf16_t* gA = (const pg8::bf16_t*)p.XN; const pg8::bf16_t* gB = (const pg8::bf16_t*)p.WIN_T; asm volatile("" : "+s"(gA), "+s"(gB));
            pg8::Gemm g{gA, gB, NROW, NPAD, D}; pg8::StaticOrder S; S.init(NROW, NPAD, G, bid);
            pg8::EpiProjH E{p.P, p.GATES, p.gate_b + l * 16};
            pg8::gemm_phase<pg8::EpiProjH, pg8::StaticOrder, true, true>(ldsl + RING_OFF, g, S, E);
        }
        GRID_BAR();

        {
            PHASE_IDS();
            for (int idx = gtid; idx < NLAT * 320; idx += GT) {
                const int r = idx / 320, rem = idx % 320, hs = rem >> 5, hf = (rem >> 4) & 1, i = rem & 15;
                const int t = r & (T - 1);
                const int base = (hs < 8 ? hs * 64 : C_AK + (hs - 8) * 64) + hf * 32;
                h16* pp = p.P + (size_t)r * PW + base;
                const float a1 = (float)pp[i], a2 = (float)pp[16 + i];
                const float pos = (float)(hf == 0 ? (t >> 6) : (t & 63));
                const float inv = powf(10000.0f, -(float)i / 16.0f);
                const float ang = pos * inv; const float cs = cosf(ang), sn = sinf(ang);
                pp[i] = (h16)(a1 * cs - a2 * sn); pp[16 + i] = (h16)(a2 * cs + a1 * sn);
            }
            const float* cw = p.conv_w + (size_t)l * 5 * 1024; const float* cb = p.conv_b + l * 1024;
            for (int idx = gtid; idx < NROW * 1024; idx += GT) {
                const int r = idx >> 10, c = idx & 1023;
                int t, len; if (r < NLAT) { t = r & (T - 1); len = T; } else { t = (r - NLAT) & (LC - 1); len = LC; }
                float y = cb[c];
#pragma unroll
                for (int j = 0; j < 5; ++j) { const int tt = t + j - 2; if (tt >= 0 && tt < len) y += cw[j * 1024 + c] * (float)p.P[(size_t)(r + j - 2) * PW + C_MQ + c]; }
                p.CQK[(size_t)r * 1024 + c] = (h16)silu_f(y);
            }
        }
        GRID_BAR();

        {
            PHASE_IDS();
            const float* sink = p.sink + l * 8;
            attn_phase(ldsl, p.P, sink, p.XN, bid, G, last ? 256 : 288);
            LAS float* sq = (LAS float*)ldsl; LAS float* sk = sq + 16 * 128; LAS float* sv = sk + 16 * 128; LAS float* sig = sv + 16 * 32; LAS float* sfg = sig + 16; LAS int* srow = (LAS int*)(sfg + 16);
            const int vl = tid >> 4, kg = tid & 15;
            for (int it = bid; it < NB * 4 * 4; it += G) {
                const int slice = it & 3, head = (it >> 2) & 3, b = it >> 4;
                for (int dir = 0; dir < 2; ++dir) {
                    float C[8], n[8]; float m = -INFINITY;
#pragma unroll
                    for (int i = 0; i < 8; ++i) { C[i] = 0.f; n[i] = 0.f; }
                    for (int p0 = 0; p0 < LC + T; p0 += 16) {
                        __syncthreads();
                        for (int e = tid; e < 16 * 128; e += NTHR) { const int s = e >> 7, d = e & 127; const int pp = p0 + s;
                            int row; if (pp < LC) { const int tc = dir == 0 ? pp : LC - 1 - pp; row = NLAT + b * LC + tc; } else { const int pl = pp - LC; const int tt = dir == 0 ? pl : T - 1 - pl; row = b * T + tt; }
                            sq[s * 128 + d] = (float)p.CQK[(size_t)row * 1024 + head * 128 + d];
                            sk[s * 128 + d] = (float)p.CQK[(size_t)row * 1024 + 512 + head * 128 + d] * 0.08838834764831845f;
                            if (d < 32) sv[s * 32 + d] = (float)p.P[(size_t)row * PW + C_MV + head * 128 + slice * 32 + d];
                            if (d == 0) { sig[s] = p.GATES[(size_t)row * 16 + dir * 4 + head]; sfg[s] = p.GATES[(size_t)row * 16 + 8 + dir * 4 + head]; srow[s] = row; } }
                        __syncthreads();
                        for (int s = 0; s < 16; ++s) {
                            const float fp = sfg[s], ip = sig[s];
                            const float lf = fminf(fp, 0.f) - log1pf(expf(-fabsf(fp)));
                            const float mn = fmaxf(lf + m, ip);
                            const float fs = expf(lf + m - mn), is_ = expf(ip - mn);
                            const float vv = sv[s * 32 + vl] * is_;
                            float num = 0.f, den = 0.f;
#pragma unroll
                            for (int i = 0; i < 8; ++i) { const float kk = sk[s * 128 + kg + 16 * i], qq = sq[s * 128 + kg + 16 * i];
                                C[i] = fs * C[i] + vv * kk; n[i] = fs * n[i] + is_ * kk; num += C[i] * qq; den += n[i] * qq; }
                            num += __shfl_xor(num, 1); num += __shfl_xor(num, 2); num += __shfl_xor(num, 4); num += __shfl_xor(num, 8);
                            den += __shfl_xor(den, 1); den += __shfl_xor(den, 2); den += __shfl_xor(den, 4); den += __shfl_xor(den, 8);
                            const float h = num / fmaxf(fabsf(den), expf(-mn));
                            m = mn;
                            if (kg == 0) { h16* hp = p.H + (size_t)srow[s] * 512 + head * 128 + slice * 32 + vl; if (dir == 0) *hp = (h16)h; else *hp = (h16)((float)*hp + h); }
                        }
                    }
                }
            }
            __syncthreads();
        }
        GRID_BAR();

        {
            PHASE_IDS();
            const float* hg = p.head_g + l * 512;
            const int nw = (last ? NLAT : NROW) * 4;
            for (int w = gw; w < nw; w += NGW) {
                const int r = w >> 2, head = w & 3; const int c0 = head * 128 + lane, c1 = c0 + 64;
                const float hs0 = (float)p.H[(size_t)r * 512 + c0], hs1 = (float)p.H[(size_t)r * 512 + c1];
                const float h0 = sigmoid_f((float)p.P[(size_t)r * PW + C_MO + c0]) * hs0;
                const float h1 = sigmoid_f((float)p.P[(size_t)r * PW + C_MO + c1]) * hs1;
                const float ms = wave_sum(h0 * h0 + h1 * h1) * (1.f / 128.f);
                const float rstd = 1.0f / sqrtf(ms + EPS);
                p.XN[(size_t)r * D + 512 + c0] = (h16)(h0 * rstd * hg[c0] * silu_f((float)p.P[(size_t)r * PW + C_MZ + c0]));
                p.XN[(size_t)r * D + 512 + c1] = (h16)(h1 * rstd * hg[c1] * silu_f((float)p.P[(size_t)r * PW + C_MZ + c1]));
            }
        }
        GRID_BAR();

        {
            const int M = last ? NLAT : NROW;
            const pg8::bf16_t* gA = (const pg8::bf16_t*)p.XN; const pg8::bf16_t* gB = (const pg8::bf16_t*)p.WOUT_T; asm volatile("" : "+s"(gA), "+s"(gB));
            pg8::Gemm g{gA, gB, M, D, D}; pg8::StaticOrder S; S.init(M, D, G, bid);
            pg8::EpiResF E{xin_lat, xin_ctx, p.out, p.XC, MODl};
            pg8::gemm_phase<pg8::EpiResF, pg8::StaticOrder, true, true>(ldsl + RING_OFF, g, S, E);
        }
        GRID_BAR();
    }

    {
        PHASE_IDS();
        const float* g = p.final_g;
        for (int row = gw; row < NLAT; row += NGW) {
            float* xr = p.out + (size_t)row * D;
            f32x4 v[4]; float ss = 0.f;
#pragma unroll
            for (int j = 0; j < 4; ++j) { v[j] = *(const f32x4*)(xr + (j * 64 + lane) * 4); ss += v[j].x * v[j].x + v[j].y * v[j].y + v[j].z * v[j].z + v[j].w * v[j].w; }
            ss = wave_sum(ss);
            const float rstd = 1.0f / sqrtf(ss * (1.f / D) + EPS);
#pragma unroll
            for (int j = 0; j < 4; ++j) { const int k = (j * 64 + lane) * 4; const f32x4 gg = *(const f32x4*)(g + k); *(f32x4*)(xr + k) = v[j] * rstd * gg; }
        }
    }
#undef GRID_BAR
}

extern "C" void kernel_launch(void* const* d_in, const int* in_sizes, int n_in, void* d_out, int out_size, void* d_ws, size_t ws_size, hipStream_t stream) {
    static int grid = 0;
    if (grid == 0) {
        int dev = 0, cus = 0, per_cu = 0;
        if (hipGetDevice(&dev) != hipSuccess || hipDeviceGetAttribute(&cus, hipDeviceAttributeMultiprocessorCount, dev) != hipSuccess) { fprintf(stderr, "kernel_launch: device query failed\n"); grid = -1; return; }
        if (hipFuncSetAttribute((const void*)fwd_megakernel, hipFuncAttributeMaxDynamicSharedMemorySize, LDS_BYTES) != hipSuccess) { fprintf(stderr, "kernel_launch: hipFuncSetAttribute failed\n"); grid = -1; return; }
        if (hipOccupancyMaxActiveBlocksPerMultiprocessor(&per_cu, (const void*)fwd_megakernel, NTHR, LDS_BYTES) != hipSuccess || per_cu < 1) { fprintf(stderr, "kernel_launch: occupancy query reports %d\n", per_cu); per_cu = 1; }
        (void)hipGetLastError();
        grid = cus;
        fprintf(stderr, "kernel_launch: cus %d per_cu %d grid %d\n", cus, per_cu, grid);
    }
    if (grid < 0) return;
    unsigned char* ws = (unsigned char*)d_ws; size_t off = 0;
    auto carve = [&](size_t bytes) { unsigned char* q = ws + off; off += (bytes + 255) & ~(size_t)255; return q; };
    Params p{};
    p.ctl = (unsigned*)carve(CTL_ZERO_BYTES);
    p.P = (h16*)carve((size_t)NROW * PW * 2);
    p.XN = (h16*)carve((size_t)NROW * D * 2);
    p.XC = (float*)carve((size_t)NCTX * D * 4);
    p.CQK = (h16*)carve((size_t)NROW * 1024 * 2);
    p.H = (h16*)carve((size_t)NROW * 512 * 2);
    p.GATES = (float*)carve((size_t)NROW * 16 * 4);
    p.MOD = (float*)carve((size_t)DEPTH * 9 * 3072 * 4);
    p.WIN_T = (h16*)carve((size_t)NPAD * D * 2);
    p.WOUT_T = (h16*)carve((size_t)D * D * 2);
    if (off > ws_size) { fprintf(stderr, "kernel_launch: workspace too small: need %zu have %zu\n", off, ws_size); return; }
    p.x = (const float*)d_in[0]; p.c = (const float*)d_in[1]; p.ctx = (const float*)d_in[2]; p.c_ctx = (const float*)d_in[3];
    p.w_ada = (const float*)d_in[4]; p.b_ada = (const float*)d_in[5]; p.norm_g = (const float*)d_in[6]; p.w_in = (const float*)d_in[7];
    p.conv_w = (const float*)d_in[8]; p.conv_b = (const float*)d_in[9]; p.gate_b = (const float*)d_in[10]; p.sink = (const float*)d_in[11];
    p.head_g = (const float*)d_in[12]; p.w_out = (const float*)d_in[13]; p.final_g = (const float*)d_in[14];
    p.out = (float*)d_out;
    if (hipMemsetAsync(p.ctl, 0, CTL_ZERO_BYTES, stream) != hipSuccess) { fprintf(stderr, "kernel_launch: memset failed\n"); return; }
    hipLaunchKernelGGL(fwd_megakernel, dim3(grid), dim3(NTHR), LDS_BYTES, stream, p);
}
```

```cpp
#include <hip/hip_runtime.h>
#include <cstdint>
#include <cstdio>

typedef _Float16 h16;

constexpr int NB = 8, T = 2048, D = 1024, DEPTH = 4, LC = 256;
constexpr int NLAT = NB * T, NCTX = NB * LC, NROW = NLAT + NCTX;
constexpr int INC = 3856, PW = 3840, NPAD = 4096;
constexpr int C_AQ = 0, C_AK = 512, C_AV = 640, C_AZ = 768, C_MQ = 1280, C_MK = 1792, C_MV = 2304, C_MO = 2816, C_MZ = 3328, C_MI = 3840;
constexpr float EPS = 1e-6f;
constexpr int NTHR = 512, NWAVES = 8;

typedef _Float16 h16x2 __attribute__((ext_vector_type(2)));
__device__ __forceinline__ unsigned pkh(float lo, float hi) { h16x2 v = {(h16)lo, (h16)hi}; return __builtin_bit_cast(unsigned, v); }

namespace pg8 {
#define PG8_LAS __attribute__((address_space(3)))
typedef unsigned short bf16_t;
typedef short bf16x8 __attribute__((ext_vector_type(8)));
typedef float f32x4 __attribute__((ext_vector_type(4)));
typedef unsigned u32x4 __attribute__((ext_vector_type(4)));
typedef _Float16 h16x8 __attribute__((ext_vector_type(8)));
constexpr int BM = 256, BK = 64, HALF = 128, HTB = HALF * BK * 2  , STAGE_BYTES = 8 * HTB, NXCD = 8, WGM = 8;

__host__ __device__ __forceinline__ int lds_byte(int r, int c) { const int st = (r >> 4) * 2 + (c >> 5), rr = r & 15, cc = c & 31, ob = rr * 64 + cc * 2; return st * 1024 + (ob ^ (((ob >> 9) & 1) << 5)); }
__host__ __device__ __forceinline__ void stage_rc(int b, int& R, int& C) { const int st = b / 1024, sb = b % 1024, swz = sb ^ (((sb >> 9) & 1) << 5); R = (st >> 1) * 16 + swz / 64; C = (st & 1) * 32 + (swz % 64) / 2; }
__host__ __device__ __forceinline__ int perm32(int rho) { const int n = rho >> 4, i = rho & 15; return 8 * (i >> 2) + 4 * n + (i & 3); }

struct Unit { int pm, pn; };
struct Gemm { const bf16_t* A; const bf16_t* Bt; int M, N, K; };

struct StaticOrder {
    int nM, nN, nwg, G, c;
    __host__ __device__ void init(int M, int N, int G_, int c_) { nM = M / BM; nN = N / BM; nwg = nM * nN; G = G_; c = c_; }
    __host__ __device__ bool next(int i, Unit& u) const {
        const long L = (long)i * G + c; if (L >= nwg) return false;
        int wgid = (int)L; { const int q = nwg / NXCD, r = nwg % NXCD, xcd = wgid % NXCD, off = wgid / NXCD; wgid = (xcd < r ? xcd * (q + 1) : r * (q + 1) + (xcd - r) * q) + off; }
        const int nig = WGM * nN, gid = wgid / nig, fm = gid * WGM, gsz = (nM - fm) < WGM ? (nM - fm) : WGM;
        u.pm = fm + ((wgid % nig) % gsz); u.pn = (wgid % nig) / gsz; return true;
    }
    __device__ __forceinline__ void a_ready(const Unit&) const {}
    __device__ __forceinline__ void done(const Unit&) const {}
};

struct EpiProjH {
    static constexpr bool PERM = true, AFTER_DRAIN = false;
    h16* P; float* GATES; const float* gate_b;
    __device__ __forceinline__ void operator()(const f32x4 (&acc)[2][2][4][2], const Unit& u, int wr, int wc, int fr, int fq) const {
        const int row0 = u.pm * BM + wr * 64 + fr;
        if (u.pn < 15) {
            const int col0 = u.pn * BM + wc * 32 + 8 * fq;
#pragma unroll
            for (int ai = 0; ai < 2; ++ai)
#pragma unroll
                for (int m = 0; m < 4; ++m) { h16* rowp = P + (size_t)(row0 + ai * HALF + m * 16) * PW + col0;
#pragma unroll
                    for (int bj = 0; bj < 2; ++bj) { const f32x4 v0 = acc[ai][bj][m][0], v1 = acc[ai][bj][m][1];
                        u32x4 w; w.x = pkh(v0[0], v0[1]); w.y = pkh(v0[2], v0[3]); w.z = pkh(v1[0], v1[1]); w.w = pkh(v1[2], v1[3]);
                        *(u32x4*)(rowp + bj * HALF) = w; } }
        } else if (wc == 0 && fq < 2) {
            const f32x4 b0 = *(const f32x4*)(gate_b + 8 * fq), b1 = *(const f32x4*)(gate_b + 8 * fq + 4);
#pragma unroll
            for (int ai = 0; ai < 2; ++ai)
#pragma unroll
                for (int m = 0; m < 4; ++m) { float* gp = GATES + (size_t)(row0 + ai * HALF + m * 16) * 16 + 8 * fq;
                    *(f32x4*)gp = acc[ai][0][m][0] + b0; *(f32x4*)(gp + 4) = acc[ai][0][m][1] + b1; }
        }
    }
};
struct EpiResF {
    static constexpr bool PERM = false, AFTER_DRAIN = false;
    const float* xin_lat; const float* xin_ctx; float* xout_lat; float* xout_ctx; const float* MODl;
    __device__ __forceinline__ void operator()(const f32x4 (&acc)[2][2][4][2], const Unit& u, int wr, int wc, int fr, int fq) const {
        const int row0 = u.pm * BM + wr * 64 + fr, col0 = u.pn * BM + wc * 32 + 4 * fq;
#pragma unroll
        for (int ai = 0; ai < 2; ++ai)
#pragma unroll
            for (int m = 0; m < 4; ++m) { const int r = row0 + ai * HALF + m * 16;
                const float* xi = r < NLAT ? xin_lat + (size_t)r * D : xin_ctx + (size_t)(r - NLAT) * D;
                float* xo = r < NLAT ? xout_lat + (size_t)r * D : xout_ctx + (size_t)(r - NLAT) * D;
                const float* gate = MODl + (r < NLAT ? (r >> 11) : 8) * 3072 + 2048;
#pragma unroll
                for (int bj = 0; bj < 2; ++bj)
#pragma unroll
                    for (int n = 0; n < 2; ++n) { const int c = col0 + bj * HALF + n * 16;
                        const f32x4 xv = *(const f32x4*)(xi + c), gv = *(const f32x4*)(gate + c);
                        *(f32x4*)(xo + c) = xv + gv * acc[ai][bj][m][n]; } }
    }
};

template <class Epi, class Sched, bool ALIGN_EPI = false, bool SP2 = false>
__device__ __forceinline__ void gemm_phase(PG8_LAS unsigned char* lds, const Gemm g, const Sched& S, const Epi& E) {
    int tid_l = threadIdx.x; asm volatile("" : "+v"(tid_l));
    const int tid = tid_l, wid = __builtin_amdgcn_readfirstlane(tid >> 6), lane = tid & 63, wr = wid >> 2, wc = wid & 3, fr = lane & 15, fq = lane >> 4;
    const int K = g.K, nt = K / BK;
    unsigned voffA[2], voffB[2];
#pragma unroll
    for (int i = 0; i < 2; ++i) { int R, C; stage_rc(tid * 16 + i * 8192, R, C); const int Rb = Epi::PERM ? ((R & ~31) + perm32(R & 31)) : R;
        voffA[i] = (unsigned)(R * K + C) * 2u; voffB[i] = (unsigned)(Rb * K + C) * 2u; }
    const size_t kstep = (size_t)(BK * 2);
    const size_t hstep = (size_t)HALF * K * 2;
    const size_t tstep = 2 * hstep;
    const unsigned ldsw = (unsigned)wid * 1024u;
    const int aoff = lds_byte(wr * 64 + fr, fq * 8), boff = lds_byte(wc * 32 + fr, fq * 8);
#define PG8_SA(b, h) (((b) * 2 + (h)) * HTB)
#define PG8_SB(b, h) ((4 + (b) * 2 + (h)) * HTB)
#define PG8_STAGE(bufoff, gbase, voff) do { _Pragma("unroll") for (int _i = 0; _i < 2; ++_i) \
        __builtin_amdgcn_global_load_lds((const unsigned*)((const char*)(gbase) + (voff)[_i]), (PG8_LAS unsigned*)(lds + (bufoff) + ldsw + _i * 8192), 16, 0, 0); } while (0)
#define PG8_LDA(dst, b, h) do { _Pragma("unroll") for (int m = 0; m < 4; ++m) _Pragma("unroll") for (int k = 0; k < 2; ++k) dst[m][k] = *(const PG8_LAS h16x8*)(lds + PG8_SA(b, h) + aoff + m * 2048 + k * 1024); } while (0)
#define PG8_LDB(dst, b, h) do { _Pragma("unroll") for (int n = 0; n < 2; ++n) _Pragma("unroll") for (int k = 0; k < 2; ++k) dst[n][k] = *(const PG8_LAS h16x8*)(lds + PG8_SB(b, h) + boff + n * 2048 + k * 1024); } while (0)
#define PG8_MMA(ai, bj, At, Bt) do { __builtin_amdgcn_s_setprio(1); _Pragma("unroll") for (int m = 0; m < 4; ++m) _Pragma("unroll") for (int n = 0; n < 2; ++n) _Pragma("unroll") for (int k = 0; k < 2; ++k) \
        acc[ai][bj][m][n] = __builtin_amdgcn_mfma_f32_16x16x32_f16(Bt[n][k], At[m][k], acc[ai][bj][m][n], 0, 0, 0); __builtin_amdgcn_s_setprio(0); } while (0)
#define PG8_WAIT_V(n) asm volatile("s_waitcnt vmcnt(" #n ")" ::: "memory")
#define PG8_WAIT_L(n) asm volatile("s_waitcnt lgkmcnt(" #n ")" ::: "memory")
#define PG8_BAR __builtin_amdgcn_s_barrier()
#define PG8_SCHED __builtin_amdgcn_sched_barrier(0)
    Unit cur, nxt; int ui = 0;
    if (!S.next(0, cur)) return;
    f32x4 acc[2][2][4][2];
#pragma unroll
    for (int a = 0; a < 2; ++a)
#pragma unroll
        for (int b = 0; b < 2; ++b)
#pragma unroll
            for (int m = 0; m < 4; ++m)
#pragma unroll
                for (int n = 0; n < 2; ++n) acc[a][b][m][n] = (f32x4){0.f, 0.f, 0.f, 0.f};
    h16x8 At[4][2], B0[2][2], B1[2][2];
    const char* cA = (const char*)g.A + (size_t)cur.pm * tstep; const char* cB = (const char*)g.Bt + (size_t)cur.pn * tstep;
    S.a_ready(cur);
    if constexpr (SP2) {
        PG8_STAGE(PG8_SB(0, 0), cB, voffB); PG8_STAGE(PG8_SB(0, 1), cB + hstep, voffB); PG8_STAGE(PG8_SA(0, 0), cA, voffA); PG8_STAGE(PG8_SA(0, 1), cA + hstep, voffA);
        if (wr == 1) PG8_BAR;
        PG8_WAIT_V(2); PG8_BAR;
        PG8_STAGE(PG8_SB(1, 0), cB + kstep, voffB); PG8_STAGE(PG8_SA(1, 0), cA + kstep, voffA); PG8_STAGE(PG8_SB(1, 1), cB + hstep + kstep, voffB);
        PG8_WAIT_V(6); PG8_BAR;
    } else {
        PG8_STAGE(PG8_SB(0, 0), cB, voffB); PG8_STAGE(PG8_SA(0, 0), cA, voffA); PG8_STAGE(PG8_SB(0, 1), cB + hstep, voffB); PG8_STAGE(PG8_SA(0, 1), cA + hstep, voffA);
        if (wr == 1) PG8_BAR;
        PG8_WAIT_V(4); PG8_BAR;
        PG8_STAGE(PG8_SB(1, 0), cB + kstep, voffB); PG8_STAGE(PG8_SA(1, 0), cA + kstep, voffA); PG8_STAGE(PG8_SB(1, 1), cB + hstep + kstep, voffB);
        PG8_WAIT_V(6); PG8_BAR;
    }
    for (;;) {
        const bool has_next = S.next(ui + 1, nxt);
        const char* nA = has_next ? (const char*)g.A + (size_t)nxt.pm * tstep : cA; const char* nB = has_next ? (const char*)g.Bt + (size_t)nxt.pn * tstep : cB;
        for (int t = 0; t < nt; t += 2) {
            const bool last = (t == nt - 2);
            const char* a1 = cA + (size_t)(t + 1) * kstep;
            const char* a2 = last ? nA : cA + (size_t)(t + 2) * kstep; const char* b2 = last ? nB : cB + (size_t)(t + 2) * kstep;
            const char* a3 = a2 + kstep; const char* b3 = b2 + kstep;
            if (last && has_next) S.a_ready(nxt);
            if constexpr (SP2) {
            PG8_LDB(B0, 0, 0); PG8_LDB(B1, 0, 1); PG8_SCHED; PG8_LDA(At, 0, 0); PG8_STAGE(PG8_SA(1, 1), a1 + hstep, voffA);
            PG8_WAIT_V(8); PG8_WAIT_L(0); PG8_BAR; PG8_MMA(0, 0, At, B0); PG8_MMA(0, 1, At, B1); PG8_BAR; PG8_SCHED;
            PG8_LDA(At, 0, 1); PG8_STAGE(PG8_SB(0, 0), b2, voffB); PG8_STAGE(PG8_SB(0, 1), b2 + hstep, voffB); PG8_STAGE(PG8_SA(0, 0), a2, voffA);
            PG8_WAIT_V(8); PG8_WAIT_L(0); PG8_BAR; PG8_MMA(1, 0, At, B0); PG8_MMA(1, 1, At, B1); PG8_BAR; PG8_SCHED;
            PG8_LDB(B0, 1, 0); PG8_LDB(B1, 1, 1); PG8_SCHED; PG8_LDA(At, 1, 0); PG8_STAGE(PG8_SA(0, 1), a2 + hstep, voffA);
            PG8_WAIT_V(8); PG8_WAIT_L(0); PG8_BAR; PG8_MMA(0, 0, At, B0); PG8_MMA(0, 1, At, B1); PG8_BAR; PG8_SCHED;
            PG8_LDA(At, 1, 1); PG8_STAGE(PG8_SB(1, 0), b3, voffB); PG8_STAGE(PG8_SB(1, 1), b3 + hstep, voffB); PG8_STAGE(PG8_SA(1, 0), a3, voffA);
            PG8_WAIT_V(8); PG8_WAIT_L(0); PG8_BAR; PG8_MMA(1, 0, At, B0); PG8_MMA(1, 1, At, B1); PG8_BAR; PG8_SCHED;
            } else {
            PG8_LDB(B0, 0, 0); PG8_SCHED; PG8_LDA(At, 0, 0); PG8_STAGE(PG8_SA(1, 1), a1 + hstep, voffA);
            PG8_WAIT_L(8); PG8_BAR; PG8_WAIT_L(0); PG8_MMA(0, 0, At, B0); PG8_BAR; PG8_SCHED;
            PG8_LDB(B1, 0, 1); PG8_STAGE(PG8_SB(0, 0), b2, voffB);
            PG8_BAR; PG8_WAIT_L(0); PG8_MMA(0, 1, At, B1); PG8_BAR;
            PG8_LDA(At, 0, 1); PG8_STAGE(PG8_SA(0, 0), a2, voffA);
            PG8_BAR; PG8_WAIT_L(0); PG8_MMA(1, 0, At, B0); PG8_BAR; PG8_SCHED;
            PG8_STAGE(PG8_SB(0, 1), b2 + hstep, voffB);
            PG8_WAIT_V(6); PG8_BAR; PG8_MMA(1, 1, At, B1); PG8_BAR;
            PG8_LDB(B0, 1, 0); PG8_SCHED; PG8_LDA(At, 1, 0); PG8_STAGE(PG8_SA(0, 1), a2 + hstep, voffA);
            PG8_WAIT_L(8); PG8_BAR; PG8_WAIT_L(0); PG8_MMA(0, 0, At, B0); PG8_BAR; PG8_SCHED;
            PG8_LDB(B1, 1, 1); PG8_STAGE(PG8_SB(1, 0), b3, voffB);
            PG8_BAR; PG8_WAIT_L(0); PG8_MMA(0, 1, At, B1); PG8_BAR;
            PG8_LDA(At, 1, 1); PG8_STAGE(PG8_SA(1, 0), a3, voffA);
            PG8_BAR; PG8_WAIT_L(0); PG8_MMA(1, 0, At, B0); PG8_BAR; PG8_SCHED;
            PG8_STAGE(PG8_SB(1, 1), b3 + hstep, voffB);
            PG8_WAIT_V(6); PG8_BAR; PG8_MMA(1, 1, At, B1); PG8_BAR;
            }
        }
        if constexpr (ALIGN_EPI) { if (wr == 0) PG8_BAR; }
        if constexpr (!Epi::AFTER_DRAIN) { E(acc, cur, wr, wc, fr, fq); S.done(cur); }
        if (!has_next) break;
#pragma unroll
        for (int a = 0; a < 2; ++a)
#pragma unroll
            for (int b = 0; b < 2; ++b)
#pragma unroll
                for (int m = 0; m < 4; ++m)
#pragma unroll
                    for (int n = 0; n < 2; ++n) acc[a][b][m][n] = (f32x4){0.f, 0.f, 0.f, 0.f};
        cur = nxt; cA = nA; cB = nB; ++ui;
        if constexpr (ALIGN_EPI) { if (wr == 1) PG8_BAR; }
    }
    PG8_WAIT_V(0);
    if constexpr (!ALIGN_EPI) { if (wr == 0) PG8_BAR; }
    PG8_BAR;
    if constexpr (Epi::AFTER_DRAIN) { E.fused(acc, cur, wr, wc, fr, fq, lds, wid, lane); S.done(cur); }
#undef PG8_SA
#undef PG8_SB
#undef PG8_STAGE
#undef PG8_LDA
#undef PG8_LDB
#undef PG8_MMA
#undef PG8_WAIT_V
#undef PG8_WAIT_L
#undef PG8_BAR
#undef PG8_SCHED
}
}

#define GAS __attribute__((address_space(1)))
#define LAS __attribute__((address_space(3)))
typedef unsigned short bf16;
typedef unsigned v4u __attribute__((ext_vector_type(4)));
typedef float f32x4 __attribute__((ext_vector_type(4)));
typedef short bf16x8 __attribute__((ext_vector_type(8)));
typedef GAS unsigned gu32;
typedef GAS unsigned long long gu64;
#define RLX_AGENT __ATOMIC_RELAXED, __HIP_MEMORY_SCOPE_AGENT
#define LDS_WAIT() asm volatile("s_waitcnt lgkmcnt(0)" ::: "memory")
#define VM_WAIT() asm volatile("s_waitcnt vmcnt(0)" ::: "memory")
__device__ __forceinline__ unsigned long long rt() { return __builtin_amdgcn_s_memrealtime(); }
__device__ __forceinline__ unsigned f2bf(float f) { unsigned u = __builtin_bit_cast(unsigned, f); return (u + 0x7fffu + ((u >> 16) & 1u)) >> 16; }
__device__ __forceinline__ unsigned pk2(float lo, float hi) { return f2bf(lo) | (f2bf(hi) << 16); }
#define XB_TMO      128
#define XB_XCNT(j)  (256  + 64 * (j))
#define XB_XSUB(j)  (1280 + 64 * (j))
#define XB_XGEN(j)  (2304 + 64 * (j))
#define XB_TOP      3328
#define XB_TOPGEN   3392
#define XCD_BAR_WORDS 3456
#define XB_SPIN_CAP (1u << 18)

__device__ __forceinline__ unsigned xb_ld(unsigned* p)              { return __hip_atomic_load(p, __ATOMIC_RELAXED, __HIP_MEMORY_SCOPE_AGENT); }
__device__ __forceinline__ unsigned xb_add(unsigned* p, unsigned v) { return __hip_atomic_fetch_add(p, v, __ATOMIC_RELAXED, __HIP_MEMORY_SCOPE_AGENT); }
__device__ __forceinline__ unsigned xb_xcc_id() { return (unsigned)__builtin_amdgcn_s_getreg((3 << 11) | 20) & 0xFu; }
#define XB_SPIN(cond, bar) do { unsigned _sp = 0; while (cond) { __builtin_amdgcn_s_sleep(1); \
    if ((++_sp & 255u) == 0u) { if (xb_ld(&(bar)[XB_TMO])) break; if (_sp > XB_SPIN_CAP) { atomicAdd(&(bar)[XB_TMO], 1u); break; } } } } while (0)

struct XcdBarrier {
    unsigned* bar; unsigned x;
    volatile LAS unsigned* st;
};

__device__ __forceinline__ XcdBarrier xcd_barrier_post(unsigned* bar, volatile LAS unsigned* st) {
    XcdBarrier b; b.bar = bar; b.x = (unsigned)__builtin_amdgcn_readfirstlane((int)xb_xcc_id()); b.st = st;
    if (threadIdx.x == 0) (void)xb_add(&bar[XB_XCNT(b.x)], 1u);
    return b;
}
__device__ __forceinline__ void xcd_barrier_complete(unsigned* bar, unsigned x, unsigned& nloc, unsigned& nx) {
    const unsigned G = gridDim.x * gridDim.y * gridDim.z;
    unsigned sum, cnt, mine, sp = 0u;
    for (;;) {
        sum = 0u; cnt = 0u; mine = 0u;
#pragma unroll
        for (unsigned j = 0; j < 16; ++j) { const unsigned c = xb_ld(&bar[XB_XCNT(j)]); sum += c; cnt += (c > 0u) ? 1u : 0u; mine = (j == x) ? c : mine; }
        if (sum == G) break;
        __builtin_amdgcn_s_sleep(1);
        if ((++sp & 255u) == 0u) { if (xb_ld(&bar[XB_TMO])) break; if (sp > XB_SPIN_CAP) { atomicAdd(&bar[XB_TMO], 1u); break; } }
    }
    nloc = mine > 0u ? mine : 1u; nx = cnt > 0u ? cnt : 1u;
}

__device__ __forceinline__ void xcd_barrier(const XcdBarrier& b) {
    asm volatile("s_waitcnt vmcnt(0)" ::: "memory");
    __syncthreads();
    if (threadIdx.x == 0) {
        unsigned* bar = b.bar; asm volatile("" : "+s"(bar));
        __builtin_amdgcn_s_waitcnt(0);
        unsigned nloc = b.st[0], nx = b.st[1];
        if (nloc == 0u) { xcd_barrier_complete(bar, b.x, nloc, nx); b.st[0] = nloc; b.st[1] = nx; }
        const unsigned old = xb_add(&bar[XB_XSUB(b.x)], 1u);
        const unsigned gen = old / nloc;
        if (old + 1u == (gen + 1u) * nloc) {
            __builtin_amdgcn_fence(__ATOMIC_RELEASE, "agent");
            asm volatile("s_waitcnt vmcnt(0)" ::: "memory");
            const unsigned og = xb_add(&bar[XB_TOP], 1u);
            const unsigned tg = og / nx;
            if (og + 1u == (tg + 1u) * nx) xb_add(&bar[XB_TOPGEN], 1u);
            else XB_SPIN(xb_ld(&bar[XB_TOPGEN]) == tg, bar);
            __builtin_amdgcn_fence(__ATOMIC_ACQUIRE, "agent");
            xb_add(&bar[XB_XGEN(b.x)], 1u);
            asm volatile("s_waitcnt vmcnt(0)" ::: "memory");
        } else {
            XB_SPIN(xb_ld(&bar[XB_XGEN(b.x)]) == gen, bar);
            __builtin_amdgcn_fence(__ATOMIC_ACQUIRE, "agent");
            asm volatile("s_waitcnt vmcnt(0)" ::: "memory");
        }
    }
    __syncthreads();
}

constexpr int RING_OFF = 0, RING_BYTES = 131072;
constexpr int LDSCTL_OFF = RING_BYTES, MISC_OFF = LDSCTL_OFF + 320;
constexpr int LDS_BYTES = 147456;
constexpr size_t CTL_ZERO_BYTES = 64 * 1024;
constexpr int CW_BAR = 1024;

struct Params {
    const float *x, *c, *ctx, *c_ctx, *w_ada, *b_ada, *norm_g, *w_in, *conv_w, *conv_b, *gate_b, *sink, *head_g, *w_out, *final_g;
    float* out;
    unsigned* ctl;
    h16 *P, *XN, *CQK, *WIN_T, *WOUT_T;
    float *XC, *GATES, *MOD;
};

__device__ __forceinline__ float silu_f(float x) { return x / (1.f + expf(-x)); }
__device__ __forceinline__ float sigmoid_f(float x) { return 1.f / (1.f + expf(-x)); }
__device__ __forceinline__ float wave_sum(float v) {
#pragma unroll
    for (int o = 1; o < 64; o <<= 1) v += __shfl_xor(v, o);
    return v;
}

__device__ __forceinline__ void transpose_item(const float* W, int K, int N, int Npad, h16* WT, LAS float* scr, int item, int lane) {
    const int nblk = Npad / 32, kb = item / nblk, nb = item % nblk, k0 = 64 * kb, n0 = 32 * nb;
#pragma unroll 8
    for (int i = 0; i < 32; ++i) { const int kk = 2 * i + (lane >> 5); const int n = n0 + (lane & 31); scr[kk * 33 + (lane & 31)] = n < N ? W[(size_t)(k0 + kk) * N + n] : 0.f; }
    LDS_WAIT(); asm volatile("" ::: "memory");
    const int c = lane & 7;
#pragma unroll
    for (int j = 0; j < 4; ++j) { const int n = (lane >> 3) + 8 * j; const LAS float* s = scr + (8 * c) * 33 + n;
        v4u o; o.x = pkh(s[0 * 33], s[1 * 33]); o.y = pkh(s[2 * 33], s[3 * 33]); o.z = pkh(s[4 * 33], s[5 * 33]); o.w = pkh(s[6 * 33], s[7 * 33]);
        *(GAS v4u*)(WT + (size_t)(n0 + n) * K + k0 + 8 * c) = o; }
    LDS_WAIT(); asm volatile("" ::: "memory");
}


typedef short v4i16_t __attribute__((ext_vector_type(4)));
typedef _Float16 h16x4 __attribute__((ext_vector_type(4)));
typedef _Float16 h16x8 __attribute__((ext_vector_type(8)));
constexpr int AT_RB = 128, AT_TILE = 64 * AT_RB;
constexpr float AT_SC = 0.18033688011112042f, LOG2E = 1.4426950408889634f;
__device__ __forceinline__ h16x4 tr16(LAS unsigned char* p) { return __builtin_bit_cast(h16x4, __builtin_amdgcn_ds_read_tr16_b64_v4i16((LAS v4i16_t*)p)); }
__device__ __forceinline__ void attn_phase(LAS unsigned char* lds, const h16* __restrict__ P, const float* __restrict__ sink, h16* __restrict__ MIX, int bid, int G, int nitems) {
    int tid = threadIdx.x; asm volatile("" : "+v"(tid));
    const int lane = tid & 63, wave = __builtin_amdgcn_readfirstlane(tid >> 6), l15 = lane & 15, g = lane >> 4;
    const int srow = tid >> 3, sseg = tid & 7;
    for (int it = bid; it < nitems; it += G) {
        int b, hkv, n, qrow0, nch; bool isctx;
        if (it < 256) { b = it >> 5; hkv = (it >> 4) & 1; n = it & 15; qrow0 = b * T + n * 128; nch = (n == 0 || n == 15) ? 8 : 10; isctx = false; }
        else { const int j = it - 256; b = j >> 2; hkv = (j >> 1) & 1; n = j & 1; qrow0 = NLAT + b * LC + n * 128; nch = 4; isctx = true; }
        const int hq = hkv * 4 + (wave >> 1), iq0 = (wave & 1) * 64;
#define AT_CI(k) (isctx ? (k) + 6 : (k) + ((n == 0 || (n == 15 && (k) >= 4)) ? 2 : 0))
#define AT_ROW(ci) ((ci) < 6 ? b * T + (n - 1) * 128 + (ci) * 64 : NLAT + b * LC + ((ci) - 6) * 64)
        h16x8 qf[4][2];
#pragma unroll
        for (int qt = 0; qt < 4; ++qt) { const h16* qp = P + (size_t)(qrow0 + iq0 + qt * 16 + l15) * PW + C_AQ + hq * 64 + g * 8; qf[qt][0] = *(const h16x8*)qp; qf[qt][1] = *(const h16x8*)(qp + 32); }
        float m[4], lsum[4]; f32x4 O[4][4];
        const float sinkv = sink[hq] * LOG2E;
#pragma unroll
        for (int qt = 0; qt < 4; ++qt) { m[qt] = sinkv; lsum[qt] = (g == 0) ? 1.f : 0.f;
#pragma unroll
            for (int dt = 0; dt < 4; ++dt) O[dt][qt] = (f32x4){0.f, 0.f, 0.f, 0.f}; }
        const int sswz = (sseg ^ ((srow >> 1) & 7)) * 8;
#define AT_STAGE(ci_, buf_) do { const size_t r_ = (size_t)(AT_ROW(ci_) + srow); \
            __builtin_amdgcn_global_load_lds((const unsigned*)(P + r_ * PW + C_AK + hkv * 64 + sswz), (LAS unsigned*)(lds + (buf_) * AT_TILE + wave * 1024), 16, 0, 0); \
            __builtin_amdgcn_global_load_lds((const unsigned*)(P + r_ * PW + C_AV + hkv * 64 + sswz), (LAS unsigned*)(lds + (2 + (buf_)) * AT_TILE + wave * 1024), 16, 0, 0); } while (0)
        { const int ci0 = AT_CI(0); AT_STAGE(ci0, 0); }
        __syncthreads();
        for (int k = 0; k < nch; ++k) {
            const int cur = k & 1, ci = AT_CI(k);
            if (k + 1 < nch) { const int c2 = AT_CI(k + 1); AT_STAGE(c2, cur ^ 1); }
            LAS unsigned char* Kb = lds + cur * AT_TILE; LAS unsigned char* Vb = lds + (2 + cur) * AT_TILE;
            const int mtype = (ci < 2) ? 1 : ((ci == 4 || ci == 5) ? 2 : 0);
#pragma unroll 1
            for (int sub = 0; sub < 2; ++sub) {
                f32x4 s[2][4];
#pragma unroll
                for (int t = 0; t < 2; ++t) { const int kr = sub * 32 + t * 16 + l15, ksw = (kr >> 1) & 7; const LAS unsigned char* kp = Kb + kr * AT_RB;
                    const h16x8 kf0 = *(const LAS h16x8*)(kp + ((g ^ ksw) << 4)), kf1 = *(const LAS h16x8*)(kp + (((4 + g) ^ ksw) << 4));
#pragma unroll
                    for (int qt = 0; qt < 4; ++qt) { f32x4 z = (f32x4){0.f, 0.f, 0.f, 0.f}; z = __builtin_amdgcn_mfma_f32_16x16x32_f16(kf0, qf[qt][0], z, 0, 0, 0); s[t][qt] = __builtin_amdgcn_mfma_f32_16x16x32_f16(kf1, qf[qt][1], z, 0, 0, 0); } }
#pragma unroll
                for (int t = 0; t < 2; ++t)
#pragma unroll
                    for (int qt = 0; qt < 4; ++qt)
#pragma unroll
                        for (int r = 0; r < 4; ++r) { float v = s[t][qt][r] * AT_SC;
                            if (mtype) { const int jk = ci * 64 + sub * 32 + t * 16 + 4 * g + r, iq = iq0 + qt * 16 + l15; const bool ok = (mtype == 1) ? (jk >= iq) : (jk <= iq + 256); v = ok ? v : -INFINITY; }
                            s[t][qt][r] = v; }
                h16x8 pb[4];
#pragma unroll
                for (int qt = 0; qt < 4; ++qt) {
                    float mx = fmaxf(fmaxf(fmaxf(s[0][qt][0], s[0][qt][1]), fmaxf(s[0][qt][2], s[0][qt][3])), fmaxf(fmaxf(s[1][qt][0], s[1][qt][1]), fmaxf(s[1][qt][2], s[1][qt][3])));
                    mx = fmaxf(mx, __shfl_xor(mx, 16)); mx = fmaxf(mx, __shfl_xor(mx, 32));
                    const float mn = fmaxf(m[qt], mx); const float f = __builtin_amdgcn_exp2f(m[qt] - mn); m[qt] = mn;
                    float ps = 0.f;
#pragma unroll
                    for (int t = 0; t < 2; ++t)
#pragma unroll
                        for (int r = 0; r < 4; ++r) { const float pe = __builtin_amdgcn_exp2f(s[t][qt][r] - mn); s[t][qt][r] = pe; ps += pe; }
                    lsum[qt] = lsum[qt] * f + ps;
#pragma unroll
                    for (int dt = 0; dt < 4; ++dt) O[dt][qt] = O[dt][qt] * f;
                    pb[qt] = (h16x8){(h16)s[0][qt][0], (h16)s[0][qt][1], (h16)s[0][qt][2], (h16)s[0][qt][3], (h16)s[1][qt][0], (h16)s[1][qt][1], (h16)s[1][qt][2], (h16)s[1][qt][3]};
                }
#pragma unroll
                for (int dt = 0; dt < 4; ++dt) { const int vr = sub * 32 + 4 * g + (l15 >> 2), vsw = (vr >> 1) & 7, vc = 2 * dt + ((l15 >> 1) & 1);
                    LAS unsigned char* vp = Vb + vr * AT_RB + ((vc ^ vsw) << 4) + (l15 & 1) * 8;
                    const h16x4 lo = tr16(vp), hi = tr16(vp + 16 * AT_RB);
                    const h16x8 va = __builtin_shufflevector(lo, hi, 0, 1, 2, 3, 4, 5, 6, 7);
#pragma unroll
                    for (int qt = 0; qt < 4; ++qt) O[dt][qt] = __builtin_amdgcn_mfma_f32_16x16x32_f16(va, pb[qt], O[dt][qt], 0, 0, 0); }
            }
            __syncthreads();
        }
#pragma unroll
        for (int qt = 0; qt < 4; ++qt) { float lt = lsum[qt]; lt += __shfl_xor(lt, 16); lt += __shfl_xor(lt, 32); const float inv = 1.f / lt;
            const size_t qrow = (size_t)(qrow0 + iq0 + qt * 16 + l15);
#pragma unroll
            for (int dt = 0; dt < 4; ++dt) { const int d0 = dt * 16 + 4 * g;
                const h16x4 az = *(const h16x4*)(P + qrow * PW + C_AZ + hq * 64 + d0);
                const f32x4 o = O[dt][qt] * inv;
                uint2 w; w.x = pkh(o[0] * silu_f((float)az[0]), o[1] * silu_f((float)az[1])); w.y = pkh(o[2] * silu_f((float)az[2]), o[3] * silu_f((float)az[3]));
                *(uint2*)(MIX + qrow * D + hq * 64 + d0) = w; } }
#undef AT_CI
#undef AT_ROW
#undef AT_STAGE
    }
}


constexpr int ML_RS = 272;
constexpr int ML_QS = 0, ML_KS = 34816, ML_VS = 69632, ML_WV = 86016, ML_C16 = 102400, ML_NV = 119808, ML_RED = 120320, ML_SC = 122368, ML_SCB = 2816;
constexpr float ML_KSC = 0.08838834764831845f;
__device__ __forceinline__ int ml_row(int dir, int b, int p) { if (p < LC) { const int tc = dir ? LC - 1 - p : p; return NLAT + b * LC + tc; } const int pl = p - LC; const int tq = dir ? T - 1 - pl : pl; return b * T + tq; }
__device__ __forceinline__ float ml_prep(LAS unsigned char* sc, float i0, float i1, float f0, float f1, float m, int lane) {
    const float lf0 = fminf(f0, 0.f) - log1pf(expf(-fabsf(f0))), lf1 = fminf(f1, 0.f) - log1pf(expf(-fabsf(f1)));
    const float c = lf0 + lf1; float x = c;
#pragma unroll
    for (int off = 1; off < 64; off <<= 1) { const float tv = __shfl_up(x, off); if (lane >= off) x += tv; }
    const float excl = x - c, b0 = excl + lf0, b1 = excl + c;
    const float u0 = i0 - b0, u1 = i1 - b1;
    float y = fmaxf(u0, u1);
#pragma unroll
    for (int off = 1; off < 64; off <<= 1) { const float tv = __shfl_up(y, off); if (lane >= off) y = fmaxf(y, tv); }
    float exm = __shfl_up(y, 1); if (lane == 0) exm = -INFINITY;
    const float pm0 = fmaxf(exm, u0), pm1 = fmaxf(pm0, u1);
    const float M0 = fmaxf(m, pm0), M1 = fmaxf(m, pm1);
    const float Ml = __shfl(M1, 63), bL = __shfl(b1, 63);
    LAS float* f = (LAS float*)sc;
    f[2 * lane] = u0 * LOG2E; f[2 * lane + 1] = u1 * LOG2E;
    f[128 + 2 * lane] = M0 * LOG2E; f[128 + 2 * lane + 1] = M1 * LOG2E;
    f[256 + 2 * lane] = expf(m - M0); f[256 + 2 * lane + 1] = expf(m - M1);
    f[384 + 2 * lane] = expf(-(b0 + M0)); f[384 + 2 * lane + 1] = expf(-(b1 + M1));
    f[512 + 2 * lane] = expf(u0 - Ml); f[512 + 2 * lane + 1] = expf(u1 - Ml);
    if (lane == 0) f[640] = expf(m - Ml);
    return bL + Ml;
}
__device__ __forceinline__ void mlstm_item(LAS unsigned char* lds, h16* __restrict__ P, const h16* __restrict__ CQK, const float* __restrict__ GATES, int item) {
    int tid = threadIdx.x; asm volatile("" : "+v"(tid));
    const int lane = tid & 63, wave = __builtin_amdgcn_readfirstlane(tid >> 6), l15 = lane & 15, g = lane >> 4;
    const int slice = item & 1, chain = item >> 1, head = chain & 3, b = (chain >> 2) & 7, dir = chain >> 5;
    const int tt = wave < 4 ? wave : 11 - wave;
    h16* Hdst = P + (dir ? C_MK : C_MQ) + head * 128 + slice * 64;
    v4u rq[4], rk[4], rv[2]; float gi0 = 0.f, gi1 = 0.f, gf0 = 0.f, gf1 = 0.f; float mstate = -INFINITY;
#define ML_LOAD(kk) do { _Pragma("unroll") for (int i_ = 0; i_ < 4; ++i_) { const int e_ = tid + 512 * i_, r_ = e_ >> 4, c_ = e_ & 15; const size_t gr_ = (size_t)ml_row(dir, b, (kk) * 128 + r_); \
            rq[i_] = *(const v4u*)(CQK + gr_ * 1024 + head * 128 + c_ * 8); rk[i_] = *(const v4u*)(CQK + gr_ * 1024 + 512 + head * 128 + c_ * 8); } \
        _Pragma("unroll") for (int i_ = 0; i_ < 2; ++i_) { const int e_ = tid + 512 * i_, r_ = e_ >> 3, c_ = e_ & 7; const size_t gr_ = (size_t)ml_row(dir, b, (kk) * 128 + r_); \
            rv[i_] = *(const v4u*)(P + gr_ * PW + C_MV + head * 128 + slice * 64 + c_ * 8); } \
        if (wave == 0) { const size_t g0_ = (size_t)ml_row(dir, b, (kk) * 128 + 2 * lane), g1_ = (size_t)ml_row(dir, b, (kk) * 128 + 2 * lane + 1); \
            gi0 = GATES[g0_ * 16 + dir * 4 + head]; gi1 = GATES[g1_ * 16 + dir * 4 + head]; gf0 = GATES[g0_ * 16 + 8 + dir * 4 + head]; gf1 = GATES[g1_ * 16 + 8 + dir * 4 + head]; } } while (0)
#define ML_STORE(scb) do { const LAS float* ws_ = (const LAS float*)(lds + ML_SC + (scb) * ML_SCB) + 512; \
        _Pragma("unroll") for (int i_ = 0; i_ < 4; ++i_) { const int e_ = tid + 512 * i_, r_ = e_ >> 4, c_ = e_ & 15; \
            *(LAS v4u*)(lds + ML_QS + r_ * ML_RS + c_ * 16) = rq[i_]; *(LAS v4u*)(lds + ML_KS + r_ * ML_RS + c_ * 16) = rk[i_]; } \
        _Pragma("unroll") for (int i_ = 0; i_ < 2; ++i_) { const int e_ = tid + 512 * i_, r_ = e_ >> 3, c_ = e_ & 7; const int o_ = r_ * 128 + ((c_ ^ ((r_ >> 1) & 7)) << 4); \
            *(LAS v4u*)(lds + ML_VS + o_) = rv[i_]; const float w_ = ws_[r_]; const h16x8 hv_ = __builtin_bit_cast(h16x8, rv[i_]); h16x8 hw_; \
            _Pragma("unroll") for (int j_ = 0; j_ < 8; ++j_) hw_[j_] = (h16)((float)hv_[j_] * w_); \
            *(LAS h16x8*)(lds + ML_WV + o_) = hw_; } } while (0)
    ML_LOAD(0);
    for (int i = tid; i < (64 * ML_RS + 512) / 4; i += NTHR) ((LAS unsigned*)(lds + ML_C16))[i] = 0u;
    if (wave == 0) mstate = ml_prep(lds + ML_SC, gi0, gi1, gf0, gf1, mstate, lane);
    f32x4 CA[4];
#pragma unroll
    for (int vi = 0; vi < 4; ++vi) CA[vi] = (f32x4){0.f, 0.f, 0.f, 0.f};
    __syncthreads();
    ML_STORE(0);
    __syncthreads();
    for (int k = 0; k < 18; ++k) {
        LAS unsigned char* sc = lds + ML_SC + (k & 1) * ML_SCB;
        const LAS float* scf = (const LAS float*)sc;
        if (k < 17) ML_LOAD(k + 1);
        {
            h16x8 qf[4];
#pragma unroll
            for (int ks = 0; ks < 4; ++ks) qf[ks] = *(const LAS h16x8*)(lds + ML_QS + (16 * tt + l15) * ML_RS + (32 * ks + 8 * g) * 2);
            f32x4 sT[8];
#pragma unroll
            for (int si = 0; si < 8; ++si) { sT[si] = (f32x4){0.f, 0.f, 0.f, 0.f};
                if (si <= tt) {
#pragma unroll
                    for (int ks = 0; ks < 4; ++ks) { const h16x8 kf = *(const LAS h16x8*)(lds + ML_KS + (16 * si + l15) * ML_RS + (32 * ks + 8 * g) * 2); sT[si] = __builtin_amdgcn_mfma_f32_16x16x32_f16(kf, qf[ks], sT[si], 0, 0, 0); } } }
            const float M2t = scf[128 + 16 * tt + l15], wi = scf[256 + 16 * tt + l15], em = scf[384 + 16 * tt + l15];
            float rs = 0.f;
#pragma unroll
            for (int si = 0; si < 8; ++si) if (si <= tt) { const f32x4 u4 = *(const LAS f32x4*)(scf + 16 * si + 4 * g);
#pragma unroll
                for (int r = 0; r < 4; ++r) { float pe = sT[si][r] * ML_KSC * __builtin_amdgcn_exp2f(u4[r] - M2t); if (si == tt && (4 * g + r) > l15) pe = 0.f; sT[si][r] = pe; rs += pe; } }
            rs += __shfl_xor(rs, 16); rs += __shfl_xor(rs, 32);
            f32x4 NT[4];
#pragma unroll
            for (int vi = 0; vi < 4; ++vi) { f32x4 z = (f32x4){0.f, 0.f, 0.f, 0.f};
#pragma unroll
                for (int ks = 0; ks < 4; ++ks) { const h16x8 cf = *(const LAS h16x8*)(lds + ML_C16 + (16 * vi + l15) * ML_RS + (32 * ks + 8 * g) * 2); z = __builtin_amdgcn_mfma_f32_16x16x32_f16(cf, qf[ks], z, 0, 0, 0); }
                NT[vi] = z * wi; }
            float nq = 0.f;
#pragma unroll
            for (int ks = 0; ks < 4; ++ks) { const f32x4 n0 = *(const LAS f32x4*)(lds + ML_NV + (32 * ks + 8 * g) * 4), n1 = *(const LAS f32x4*)(lds + ML_NV + (32 * ks + 8 * g + 4) * 4);
                nq += n0[0] * (float)qf[ks][0] + n0[1] * (float)qf[ks][1] + n0[2] * (float)qf[ks][2] + n0[3] * (float)qf[ks][3] + n1[0] * (float)qf[ks][4] + n1[1] * (float)qf[ks][5] + n1[2] * (float)qf[ks][6] + n1[3] * (float)qf[ks][7]; }
            nq += __shfl_xor(nq, 16); nq += __shfl_xor(nq, 32); nq *= ML_KSC;
#pragma unroll
            for (int sg = 0; sg < 4; ++sg) if (2 * sg <= tt) {
                const h16x8 pb = (h16x8){(h16)sT[2 * sg][0], (h16)sT[2 * sg][1], (h16)sT[2 * sg][2], (h16)sT[2 * sg][3], (h16)sT[2 * sg + 1][0], (h16)sT[2 * sg + 1][1], (h16)sT[2 * sg + 1][2], (h16)sT[2 * sg + 1][3]};
#pragma unroll
                for (int vi = 0; vi < 4; ++vi) { const int vr = 32 * sg + 4 * g + (l15 >> 2), vc = 2 * vi + ((l15 >> 1) & 1);
                    LAS unsigned char* vp = lds + ML_VS + vr * 128 + ((vc ^ ((vr >> 1) & 7)) << 4) + (l15 & 1) * 8;
                    const h16x4 lo = tr16(vp), hi = tr16(vp + 16 * 128);
                    NT[vi] = __builtin_amdgcn_mfma_f32_16x16x32_f16(__builtin_shufflevector(lo, hi, 0, 1, 2, 3, 4, 5, 6, 7), pb, NT[vi], 0, 0, 0); } }
            const float den = wi * nq + rs; const float inv = 1.0f / fmaxf(fabsf(den), em);
            h16* hp = Hdst + (size_t)ml_row(dir, b, k * 128 + 16 * tt + l15) * PW + 4 * g;
#pragma unroll
            for (int vi = 0; vi < 4; ++vi) { const f32x4 o = NT[vi] * inv; uint2 w; w.x = pkh(o[0], o[1]); w.y = pkh(o[2], o[3]); *(uint2*)(hp + 16 * vi) = w; }
            { const int d = tid & 127, sq = tid >> 7; float part = 0.f;
#pragma unroll 8
              for (int s2 = 0; s2 < 32; ++s2) { const int s = 32 * sq + s2; part += scf[512 + s] * (float)*(const LAS h16*)(lds + ML_KS + s * ML_RS + d * 2); }
              ((LAS float*)(lds + ML_RED))[sq * 128 + d] = part; }
        }
        __syncthreads();
        {
            const float a = scf[640];
            if (k < 17) {
#pragma unroll
                for (int vi = 0; vi < 4; ++vi) CA[vi] = CA[vi] * a;
#pragma unroll
                for (int sg = 0; sg < 4; ++sg) {
                    LAS unsigned char* kp = lds + ML_KS + (32 * sg + 4 * g + (l15 >> 2)) * ML_RS + (16 * wave + 4 * (l15 & 3)) * 2;
                    const h16x4 klo = tr16(kp), khi = tr16(kp + 16 * ML_RS);
                    const h16x8 kb = __builtin_shufflevector(klo, khi, 0, 1, 2, 3, 4, 5, 6, 7);
#pragma unroll
                    for (int vi = 0; vi < 4; ++vi) { const int vr = 32 * sg + 4 * g + (l15 >> 2), vc = 2 * vi + ((l15 >> 1) & 1);
                        LAS unsigned char* vp = lds + ML_WV + vr * 128 + ((vc ^ ((vr >> 1) & 7)) << 4) + (l15 & 1) * 8;
                        const h16x4 lo = tr16(vp), hi = tr16(vp + 16 * 128);
                        CA[vi] = __builtin_amdgcn_mfma_f32_16x16x32_f16(__builtin_shufflevector(lo, hi, 0, 1, 2, 3, 4, 5, 6, 7), kb, CA[vi], 0, 0, 0); } }
#pragma unroll
                for (int vi = 0; vi < 4; ++vi)
#pragma unroll
                    for (int r = 0; r < 4; ++r) *(LAS h16*)(lds + ML_C16 + (16 * vi + 4 * g + r) * ML_RS + (16 * wave + l15) * 2) = (h16)(CA[vi][r] * ML_KSC);
                if (tid < 128) { LAS float* nv = (LAS float*)(lds + ML_NV); const LAS float* red = (const LAS float*)(lds + ML_RED); nv[tid] = a * nv[tid] + ((red[tid] + red[128 + tid]) + (red[256 + tid] + red[384 + tid])); }
                if (wave == 0) mstate = ml_prep(lds + ML_SC + ((k + 1) & 1) * ML_SCB, gi0, gi1, gf0, gf1, mstate, lane);
            }
        }
        __syncthreads();
        if (k < 17) ML_STORE((k + 1) & 1);
        __syncthreads();
    }
#undef ML_LOAD
#undef ML_STORE
}

__global__ void __launch_bounds__(NTHR, 2) fwd_megakernel(Params p) {
    extern __shared__ __attribute__((aligned(16))) unsigned char lds[];
    LAS unsigned char* ldsl = (LAS unsigned char*)lds;
    const int G = gridDim.x, bid = blockIdx.x, GT = G * NTHR, NGW = G * NWAVES;
#define PHASE_IDS() int tid = threadIdx.x; asm volatile("" : "+v"(tid)); const int lane = tid & 63, wave = __builtin_amdgcn_readfirstlane(tid >> 6); \
    const int gtid = bid * NTHR + tid, gw = bid * NWAVES + wave; (void)lane; (void)wave; (void)gtid; (void)gw
    for (int u = threadIdx.x; u < (LDS_BYTES - LDSCTL_OFF) / 4; u += NTHR) ((LAS unsigned*)(ldsl + LDSCTL_OFF))[u] = 0u;
    __syncthreads();
    volatile LAS unsigned* MISC = (volatile LAS unsigned*)(ldsl + MISC_OFF);
    XcdBarrier bar = xcd_barrier_post(p.ctl + CW_BAR, MISC + 8);
#define GRID_BAR() xcd_barrier(bar)

    {
        PHASE_IDS();
        LAS float* sc = (LAS float*)ldsl;
        LAS float* red = sc + 9 * 1024;
        for (int i = tid; i < 9 * 1024; i += NTHR) { const int r = i >> 10, k = i & 1023; const float v = (r < 8) ? p.c[r * 1024 + k] : p.c_ctx[k]; sc[i] = silu_f(v); }
        __syncthreads();
        for (int it = bid; it < DEPTH * 48; it += G) {
            const int l = it / 48, j = (it % 48) * 64 + lane;
            const float* w = p.w_ada + (size_t)l * 1024 * 3072 + j;
            float a0 = 0, a1 = 0, a2 = 0, a3 = 0, a4 = 0, a5 = 0, a6 = 0, a7 = 0, a8 = 0;
            for (int kk = 0; kk < 128; ++kk) { const int k = wave * 128 + kk; const float wv = w[(size_t)k * 3072];
                a0 += sc[0 * 1024 + k] * wv; a1 += sc[1 * 1024 + k] * wv; a2 += sc[2 * 1024 + k] * wv; a3 += sc[3 * 1024 + k] * wv; a4 += sc[4 * 1024 + k] * wv;
                a5 += sc[5 * 1024 + k] * wv; a6 += sc[6 * 1024 + k] * wv; a7 += sc[7 * 1024 + k] * wv; a8 += sc[8 * 1024 + k] * wv; }
            LAS float* rw = red + wave * 9 * 64 + lane;
            rw[0 * 64] = a0; rw[1 * 64] = a1; rw[2 * 64] = a2; rw[3 * 64] = a3; rw[4 * 64] = a4; rw[5 * 64] = a5; rw[6 * 64] = a6; rw[7 * 64] = a7; rw[8 * 64] = a8;
            __syncthreads();
            for (int e = tid; e < 9 * 64; e += NTHR) { float s = 0.f;
#pragma unroll
                for (int w8 = 0; w8 < 8; ++w8) s += red[w8 * 9 * 64 + e];
                const int r = e >> 6, jj = (it % 48) * 64 + (e & 63);
                p.MOD[((size_t)l * 9 + r) * 3072 + jj] = s + p.b_ada[l * 3072 + jj]; }
            __syncthreads();
        }
    }
    GRID_BAR();

    for (int l = 0; l < DEPTH; ++l) {
        const bool last = (l == DEPTH - 1);
        const float* MODl = p.MOD + (size_t)l * 9 * 3072;
        const float* xin_lat = (l == 0) ? p.x : p.out; const float* xin_ctx = (l == 0) ? p.ctx : p.XC;

        {
            PHASE_IDS();
            LAS float* scr = (LAS float*)(ldsl + wave * 16384);
            constexpr int I_IN = (D / 64) * (NPAD / 32), I_OUT = (D / 64) * (D / 32);
            for (int it = gw; it < I_IN + I_OUT; it += NGW) {
                if (it < I_IN) transpose_item(p.w_in + (size_t)l * D * INC, D, INC, NPAD, p.WIN_T, scr, it, lane);
                else transpose_item(p.w_out + (size_t)l * D * D, D, D, D, p.WOUT_T, scr, it - I_IN, lane);
            }
            const float* g = p.norm_g + l * D;
            for (int row = gw; row < NROW; row += NGW) {
                const float* xr = row < NLAT ? xin_lat + (size_t)row * D : xin_ctx + (size_t)(row - NLAT) * D;
                const int mr = row < NLAT ? (row >> 11) : 8;
                const float* shift = MODl + mr * 3072; const float* scale = shift + 1024;
                f32x4 v[4]; float ss = 0.f;
#pragma unroll
                for (int j = 0; j < 4; ++j) { v[j] = *(const f32x4*)(xr + (j * 64 + lane) * 4); ss += v[j].x * v[j].x + v[j].y * v[j].y + v[j].z * v[j].z + v[j].w * v[j].w; }
                ss = wave_sum(ss);
                const float rstd = 1.0f / sqrtf(ss * (1.f / D) + EPS);
#pragma unroll
                for (int j = 0; j < 4; ++j) { const int k = (j * 64 + lane) * 4;
                    const f32x4 gg = *(const f32x4*)(g + k), sc = *(const f32x4*)(scale + k), sh = *(const f32x4*)(shift + k);
                    const f32x4 o = v[j] * rstd * gg * (sc + 1.f) + sh;
                    uint2 w; w.x = pkh(o.x, o.y); w.y = pkh(o.z, o.w); *(uint2*)(p.XN + (size_t)row * D + k) = w; }
            }
        }
        GRID_BAR();

        {
            const pg8::bf16_t* gA = (const pg8::bf16_t*)p.XN; const pg8::bf16_t* gB = (const pg8::bf16_t*)p.WIN_T; asm volatile("" : "+s"(gA), "+s"(gB));
            pg8::Gemm g{gA, gB, NROW, NPAD, D}; pg8::StaticOrder S; S.init(NROW, NPAD, G, bid);
            pg8::EpiProjH E{p.P, p.GATES, p.gate_b + l * 16};
            pg8::gemm_phase<pg8::EpiProjH, pg8::StaticOrder, true, true>(ldsl + RING_OFF, g, S, E);
        }
        GRID_BAR();

        {
            PHASE_IDS();
            for (int idx = gtid; idx < NLAT * 320; idx += GT) {
                const int r = idx / 320, rem = idx % 320, hs = rem >> 5, hf = (rem >> 4) & 1, i = rem & 15;
                const int t = r & (T - 1);
                const int base = (hs < 8 ? hs * 64 : C_AK + (hs - 8) * 64) + hf * 32;
                h16* pp = p.P + (size_t)r * PW + base;
                const float a1 = (float)pp[i], a2 = (float)pp[16 + i];
                const float pos = (float)(hf == 0 ? (t >> 6) : (t & 63));
                const float inv = powf(10000.0f, -(float)i / 16.0f);
                const float ang = pos * inv; const float cs = cosf(ang), sn = sinf(ang);
                pp[i] = (h16)(a1 * cs - a2 * sn); pp[16 + i] = (h16)(a2 * cs + a1 * sn);
            }
            const float* cw = p.conv_w + (size_t)l * 5 * 1024; const float* cb = p.conv_b + l * 1024;
            for (int idx = gtid; idx < NROW * 1024; idx += GT) {
                const int r = idx >> 10, c = idx & 1023;
                int t, len; if (r < NLAT) { t = r & (T - 1); len = T; } else { t = (r - NLAT) & (LC - 1); len = LC; }
                float y = cb[c];
#pragma unroll
                for (int j = 0; j < 5; ++j) { const int tt = t + j - 2; if (tt >= 0 && tt < len) y += cw[j * 1024 + c] * (float)p.P[(size_t)(r + j - 2) * PW + C_MQ + c]; }
                p.CQK[(size_t)r * 1024 + c] = (h16)silu_f(y);
            }
        }
        GRID_BAR();

        {
            PHASE_IDS();
            const float* sink = p.sink + l * 8;
            if (bid < 128) mlstm_item(ldsl, p.P, p.CQK, p.GATES, bid);
            else attn_phase(ldsl, p.P, sink, p.XN, bid - 128, G - 128, last ? 256 : 288);
        }
        GRID_BAR();

        {
            PHASE_IDS();
            const float* hg = p.head_g + l * 512;
            const int nw = (last ? NLAT : NROW) * 4;
            for (int w = gw; w < nw; w += NGW) {
                const int r = w >> 2, head = w & 3; const int c0 = head * 128 + lane, c1 = c0 + 64;
                const float hs0 = (float)p.P[(size_t)r * PW + C_MQ + c0] + (float)p.P[(size_t)r * PW + C_MK + c0], hs1 = (float)p.P[(size_t)r * PW + C_MQ + c1] + (float)p.P[(size_t)r * PW + C_MK + c1];
                const float h0 = sigmoid_f((float)p.P[(size_t)r * PW + C_MO + c0]) * hs0;
                const float h1 = sigmoid_f((float)p.P[(size_t)r * PW + C_MO + c1]) * hs1;
                const float ms = wave_sum(h0 * h0 + h1 * h1) * (1.f / 128.f);
                const float rstd = 1.0f / sqrtf(ms + EPS);
                p.XN[(size_t)r * D + 512 + c0] = (h16)(h0 * rstd * hg[c0] * silu_f((float)p.P[(size_t)r * PW + C_MZ + c0]));
                p.XN[(size_t)r * D + 512 + c1] = (h16)(h1 * rstd * hg[c1] * silu_f((float)p.P[(size_t)r * PW + C_MZ + c1]));
            }
        }
        GRID_BAR();

        {
            const int M = last ? NLAT : NROW;
            const pg8::bf16_t* gA = (const pg8::bf16_t*)p.XN; const pg8::bf16_t* gB = (const pg8::bf16_t*)p.WOUT_T; asm volatile("" : "+s"(gA), "+s"(gB));
            pg8::Gemm g{gA, gB, M, D, D}; pg8::StaticOrder S; S.init(M, D, G, bid);
            pg8::EpiResF E{xin_lat, xin_ctx, p.out, p.XC, MODl};
            pg8::gemm_phase<pg8::EpiResF, pg8::StaticOrder, true, true>(ldsl + RING_OFF, g, S, E);
        }
        GRID_BAR();
    }

    {
        PHASE_IDS();
        const float* g = p.final_g;
        for (int row = gw; row < NLAT; row += NGW) {
            float* xr = p.out + (size_t)row * D;
            f32x4 v[4]; float ss = 0.f;
#pragma unroll
            for (int j = 0; j < 4; ++j) { v[j] = *(const f32x4*)(xr + (j * 64 + lane) * 4); ss += v[j].x * v[j].x + v[j].y * v[j].y + v[j].z * v[j].z + v[j].w * v[j].w; }
            ss = wave_sum(ss);
            const float rstd = 1.0f / sqrtf(ss * (1.f / D) + EPS);
#pragma unroll
            for (int j = 0; j < 4; ++j) { const int k = (j * 64 + lane) * 4; const f32x4 gg = *(const f32x4*)(g + k); *(f32x4*)(xr + k) = v[j] * rstd * gg; }
        }
    }
#undef GRID_BAR
}

extern "C" void kernel_launch(void* const* d_in, const int* in_sizes, int n_in, void* d_out, int out_size, void* d_ws, size_t ws_size, hipStream_t stream) {
    static int grid = 0;
    if (grid == 0) {
        int dev = 0, cus = 0, per_cu = 0;
        if (hipGetDevice(&dev) != hipSuccess || hipDeviceGetAttribute(&cus, hipDeviceAttributeMultiprocessorCount, dev) != hipSuccess) { fprintf(stderr, "kernel_launch: device query failed\n"); grid = -1; return; }
        if (hipFuncSetAttribute((const void*)fwd_megakernel, hipFuncAttributeMaxDynamicSharedMemorySize, LDS_BYTES) != hipSuccess) { fprintf(stderr, "kernel_launch: hipFuncSetAttribute failed\n"); grid = -1; return; }
        if (hipOccupancyMaxActiveBlocksPerMultiprocessor(&per_cu, (const void*)fwd_megakernel, NTHR, LDS_BYTES) != hipSuccess || per_cu < 1) { fprintf(stderr, "kernel_launch: occupancy query reports %d\n", per_cu); per_cu = 1; }
        (void)hipGetLastError();
        grid = cus;
        if (cus != 256) { fprintf(stderr, "kernel_launch: built for 256 CUs, found %d; nothing launched\n", cus); grid = -1; return; }
        fprintf(stderr, "kernel_launch: cus %d per_cu %d grid %d\n", cus, per_cu, grid);
    }
    if (grid < 0) return;
    unsigned char* ws = (unsigned char*)d_ws; size_t off = 0;
    auto carve = [&](size_t bytes) { unsigned char* q = ws + off; off += (bytes + 255) & ~(size_t)255; return q; };
    Params p{};
    p.ctl = (unsigned*)carve(CTL_ZERO_BYTES);
    p.P = (h16*)carve((size_t)NROW * PW * 2);
    p.XN = (h16*)carve((size_t)NROW * D * 2);
    p.XC = (float*)carve((size_t)NCTX * D * 4);
    p.CQK = (h16*)carve((size_t)NROW * 1024 * 2);
    p.GATES = (float*)carve((size_t)NROW * 16 * 4);
    p.MOD = (float*)carve((size_t)DEPTH * 9 * 3072 * 4);
    p.WIN_T = (h16*)carve((size_t)NPAD * D * 2);
    p.WOUT_T = (h16*)carve((size_t)D * D * 2);
    if (off > ws_size) { fprintf(stderr, "kernel_launch: workspace too small: need %zu have %zu\n", off, ws_size); return; }
    p.x = (const float*)d_in[0]; p.c = (const float*)d_in[1]; p.ctx = (const float*)d_in[2]; p.c_ctx = (const float*)d_in[3];
    p.w_ada = (const float*)d_in[4]; p.b_ada = (const float*)d_in[5]; p.norm_g = (const float*)d_in[6]; p.w_in = (const float*)d_in[7];
    p.conv_w = (const float*)d_in[8]; p.conv_b = (const float*)d_in[9]; p.gate_b = (const float*)d_in[10]; p.sink = (const float*)d_in[11];
    p.head_g = (const float*)d_in[12]; p.w_out = (const float*)d_in[13]; p.final_g = (const float*)d_in[14];
    p.out = (float*)d_out;
    if (hipMemsetAsync(p.ctl, 0, CTL_ZERO_BYTES, stream) != hipSuccess) { fprintf(stderr, "kernel_launch: memset failed\n"); return; }
    hipLaunchKernelGGL(fwd_megakernel, dim3(grid), dim3(NTHR), LDS_BYTES, stream, p);
}
```

```cpp
#include <hip/hip_runtime.h>
#include <cstdint>
#include <cstdio>

typedef _Float16 h16;

constexpr int NB = 8, T = 2048, D = 1024, DEPTH = 4, LC = 256;
constexpr int NLAT = NB * T, NCTX = NB * LC, NROW = NLAT + NCTX;
constexpr int INC = 3856, PW = 3840, NPAD = 4096, NWT = 3872;
constexpr int C_AQ = 0, C_AK = 512, C_AV = 640, C_AZ = 768, C_MQ = 1280, C_MK = 1792, C_MV = 2304, C_MO = 2816, C_MZ = 3328, C_MI = 3840;
constexpr float EPS = 1e-6f;
constexpr int NTHR = 512, NWAVES = 8;
#ifndef DUP_PHASE
#define DUP_PHASE 0
#endif
#ifndef EXTRA_BARS
#define EXTRA_BARS 0
#endif

typedef _Float16 h16x2 __attribute__((ext_vector_type(2)));
__device__ __forceinline__ unsigned pkh(float lo, float hi) { h16x2 v = {(h16)lo, (h16)hi}; return __builtin_bit_cast(unsigned, v); }

namespace pg8 {
#define PG8_LAS __attribute__((address_space(3)))
typedef unsigned short bf16_t;
typedef short bf16x8 __attribute__((ext_vector_type(8)));
typedef float f32x4 __attribute__((ext_vector_type(4)));
typedef unsigned u32x4 __attribute__((ext_vector_type(4)));
typedef _Float16 h16x8 __attribute__((ext_vector_type(8)));
constexpr int BM = 256, BK = 64, HALF = 128, HTB = HALF * BK * 2  , STAGE_BYTES = 8 * HTB, NXCD = 8, WGM = 8;

__host__ __device__ __forceinline__ int lds_byte(int r, int c) { const int st = (r >> 4) * 2 + (c >> 5), rr = r & 15, cc = c & 31, ob = rr * 64 + cc * 2; return st * 1024 + (ob ^ (((ob >> 9) & 1) << 5)); }
__host__ __device__ __forceinline__ void stage_rc(int b, int& R, int& C) { const int st = b / 1024, sb = b % 1024, swz = sb ^ (((sb >> 9) & 1) << 5); R = (st >> 1) * 16 + swz / 64; C = (st & 1) * 32 + (swz % 64) / 2; }
__host__ __device__ __forceinline__ int perm32(int rho) { const int n = rho >> 4, i = rho & 15; return 8 * (i >> 2) + 4 * n + (i & 3); }

struct Unit { int pm, pn; };
struct Gemm { const bf16_t* A; const bf16_t* Bt; int M, N, K; };

struct StaticOrder {
    int nM, nN, nwg, G, c;
    __host__ __device__ void init(int M, int N, int G_, int c_) { nM = M / BM; nN = N / BM; nwg = nM * nN; G = G_; c = c_; }
    __host__ __device__ bool next(int i, Unit& u) const {
        const long L = (long)i * G + c; if (L >= nwg) return false;
        int wgid = (int)L; { const int q = nwg / NXCD, r = nwg % NXCD, xcd = wgid % NXCD, off = wgid / NXCD; wgid = (xcd < r ? xcd * (q + 1) : r * (q + 1) + (xcd - r) * q) + off; }
        const int nig = WGM * nN, gid = wgid / nig, fm = gid * WGM, gsz = (nM - fm) < WGM ? (nM - fm) : WGM;
        u.pm = fm + ((wgid % nig) % gsz); u.pn = (wgid % nig) / gsz; return true;
    }
    __device__ __forceinline__ void a_ready(const Unit&) const {}
    __device__ __forceinline__ void done(const Unit&) const {}
};

struct EpiProjH {
    static constexpr bool PERM = true, AFTER_DRAIN = false;
    h16* P; float* GATES; const float* gate_b; const float* rope_t;
    __device__ __forceinline__ void operator()(const f32x4 (&acc)[2][2][4][2], const Unit& u, int wr, int wc, int fr, int fq) const {
        const int row0 = u.pm * BM + wr * 64 + fr;
        if (u.pn < 15) {
            const int col0 = u.pn * BM + wc * 32 + 8 * fq;
            const bool rope = (u.pm < 64) && (u.pn < 3);
            const float sgn = fq < 2 ? -1.f : 1.f;
#pragma unroll
            for (int ai = 0; ai < 2; ++ai)
#pragma unroll
                for (int m = 0; m < 4; ++m) { const int r = row0 + ai * HALF + m * 16; h16* rowp = P + (size_t)r * PW + col0;
                    f32x4 cs0 = (f32x4){1.f, 0.f, 1.f, 0.f}, cs1 = cs0, cs2 = cs0, cs3 = cs0;
                    if (rope) { const int tq = r & (T - 1); const int pos = (wc & 1) ? (tq & 63) : (tq >> 6); const float* tp = rope_t + (pos * 16 + 8 * (fq & 1)) * 2;
                        cs0 = *(const f32x4*)tp; cs1 = *(const f32x4*)(tp + 4); cs2 = *(const f32x4*)(tp + 8); cs3 = *(const f32x4*)(tp + 12); }
#pragma unroll
                    for (int bj = 0; bj < 2; ++bj) { f32x4 v0 = acc[ai][bj][m][0], v1 = acc[ai][bj][m][1];
                        if (rope && (u.pn < 2 || bj == 0)) {
                            f32x4 p0, p1;
#pragma unroll
                            for (int j = 0; j < 4; ++j) { p0[j] = __shfl_xor(v0[j], 32) * sgn; p1[j] = __shfl_xor(v1[j], 32) * sgn; }
                            v0 = (f32x4){v0[0] * cs0[0] + p0[0] * cs0[1], v0[1] * cs0[2] + p0[1] * cs0[3], v0[2] * cs1[0] + p0[2] * cs1[1], v0[3] * cs1[2] + p0[3] * cs1[3]};
                            v1 = (f32x4){v1[0] * cs2[0] + p1[0] * cs2[1], v1[1] * cs2[2] + p1[1] * cs2[3], v1[2] * cs3[0] + p1[2] * cs3[1], v1[3] * cs3[2] + p1[3] * cs3[3]}; }
                        u32x4 w; w.x = pkh(v0[0], v0[1]); w.y = pkh(v0[2], v0[3]); w.z = pkh(v1[0], v1[1]); w.w = pkh(v1[2], v1[3]);
                        *(u32x4*)(rowp + bj * HALF) = w; } }
        } else if (wc == 0 && fq < 2) {
            const f32x4 b0 = *(const f32x4*)(gate_b + 8 * fq), b1 = *(const f32x4*)(gate_b + 8 * fq + 4);
#pragma unroll
            for (int ai = 0; ai < 2; ++ai)
#pragma unroll
                for (int m = 0; m < 4; ++m) { float* gp = GATES + (size_t)(row0 + ai * HALF + m * 16) * 16 + 8 * fq;
                    *(f32x4*)gp = acc[ai][0][m][0] + b0; *(f32x4*)(gp + 4) = acc[ai][0][m][1] + b1; }
        }
    }
};
struct EpiResF {
    static constexpr bool PERM = false, AFTER_DRAIN = false;
    const float* xin_lat; const float* xin_ctx; float* xout_lat; float* xout_ctx; const float* MODl;
    __device__ __forceinline__ void operator()(const f32x4 (&acc)[2][2][4][2], const Unit& u, int wr, int wc, int fr, int fq) const {
        const int row0 = u.pm * BM + wr * 64 + fr, col0 = u.pn * BM + wc * 32 + 4 * fq;
#pragma unroll
        for (int ai = 0; ai < 2; ++ai)
#pragma unroll
            for (int m = 0; m < 4; ++m) { const int r = row0 + ai * HALF + m * 16;
                const float* xi = r < NLAT ? xin_lat + (size_t)r * D : xin_ctx + (size_t)(r - NLAT) * D;
                float* xo = r < NLAT ? xout_lat + (size_t)r * D : xout_ctx + (size_t)(r - NLAT) * D;
                const float* gate = MODl + (r < NLAT ? (r >> 11) : 8) * 3072 + 2048;
#pragma unroll
                for (int bj = 0; bj < 2; ++bj)
#pragma unroll
                    for (int n = 0; n < 2; ++n) { const int c = col0 + bj * HALF + n * 16;
                        const f32x4 xv = *(const f32x4*)(xi + c), gv = *(const f32x4*)(gate + c);
                        *(f32x4*)(xo + c) = xv + gv * acc[ai][bj][m][n]; } }
    }
};

template <class Epi, class Sched, bool ALIGN_EPI = false, bool SP2 = false>
__device__ __forceinline__ void gemm_phase(PG8_LAS unsigned char* lds, const Gemm g, const Sched& S, const Epi& E) {
    int tid_l = threadIdx.x; asm volatile("" : "+v"(tid_l));
    const int tid = tid_l, wid = __builtin_amdgcn_readfirstlane(tid >> 6), lane = tid & 63, wr = wid >> 2, wc = wid & 3, fr = lane & 15, fq = lane >> 4;
    const int K = g.K, nt = K / BK;
    unsigned voffA[2], voffB[2];
#pragma unroll
    for (int i = 0; i < 2; ++i) { int R, C; stage_rc(tid * 16 + i * 8192, R, C); const int Rb = Epi::PERM ? ((R & ~31) + perm32(R & 31)) : R;
        voffA[i] = (unsigned)(R * K + C) * 2u; voffB[i] = (unsigned)(Rb * K + C) * 2u; }
    const size_t kstep = (size_t)(BK * 2);
    const size_t hstep = (size_t)HALF * K * 2;
    const size_t tstep = 2 * hstep;
    const unsigned ldsw = (unsigned)wid * 1024u;
    const int aoff = lds_byte(wr * 64 + fr, fq * 8), boff = lds_byte(wc * 32 + fr, fq * 8);
#define PG8_SA(b, h) (((b) * 2 + (h)) * HTB)
#define PG8_SB(b, h) ((4 + (b) * 2 + (h)) * HTB)
#define PG8_STAGE(bufoff, gbase, voff) do { _Pragma("unroll") for (int _i = 0; _i < 2; ++_i) \
        __builtin_amdgcn_global_load_lds((const unsigned*)((const char*)(gbase) + (voff)[_i]), (PG8_LAS unsigned*)(lds + (bufoff) + ldsw + _i * 8192), 16, 0, 0); } while (0)
#define PG8_LDA(dst, b, h) do { _Pragma("unroll") for (int m = 0; m < 4; ++m) _Pragma("unroll") for (int k = 0; k < 2; ++k) dst[m][k] = *(const PG8_LAS h16x8*)(lds + PG8_SA(b, h) + aoff + m * 2048 + k * 1024); } while (0)
#define PG8_LDB(dst, b, h) do { _Pragma("unroll") for (int n = 0; n < 2; ++n) _Pragma("unroll") for (int k = 0; k < 2; ++k) dst[n][k] = *(const PG8_LAS h16x8*)(lds + PG8_SB(b, h) + boff + n * 2048 + k * 1024); } while (0)
#define PG8_MMA(ai, bj, At, Bt) do { __builtin_amdgcn_s_setprio(1); _Pragma("unroll") for (int m = 0; m < 4; ++m) _Pragma("unroll") for (int n = 0; n < 2; ++n) _Pragma("unroll") for (int k = 0; k < 2; ++k) \
        acc[ai][bj][m][n] = __builtin_amdgcn_mfma_f32_16x16x32_f16(Bt[n][k], At[m][k], acc[ai][bj][m][n], 0, 0, 0); __builtin_amdgcn_s_setprio(0); } while (0)
#define PG8_WAIT_V(n) asm volatile("s_waitcnt vmcnt(" #n ")" ::: "memory")
#define PG8_WAIT_L(n) asm volatile("s_waitcnt lgkmcnt(" #n ")" ::: "memory")
#define PG8_BAR __builtin_amdgcn_s_barrier()
#define PG8_SCHED __builtin_amdgcn_sched_barrier(0)
    Unit cur, nxt; int ui = 0;
    if (!S.next(0, cur)) return;
    f32x4 acc[2][2][4][2];
#pragma unroll
    for (int a = 0; a < 2; ++a)
#pragma unroll
        for (int b = 0; b < 2; ++b)
#pragma unroll
            for (int m = 0; m < 4; ++m)
#pragma unroll
                for (int n = 0; n < 2; ++n) acc[a][b][m][n] = (f32x4){0.f, 0.f, 0.f, 0.f};
    h16x8 At[4][2], B0[2][2], B1[2][2];
    const char* cA = (const char*)g.A + (size_t)cur.pm * tstep; const char* cB = (const char*)g.Bt + (size_t)cur.pn * tstep;
    S.a_ready(cur);
    if constexpr (SP2) {
        PG8_STAGE(PG8_SB(0, 0), cB, voffB); PG8_STAGE(PG8_SB(0, 1), cB + hstep, voffB); PG8_STAGE(PG8_SA(0, 0), cA, voffA); PG8_STAGE(PG8_SA(0, 1), cA + hstep, voffA);
        if (wr == 1) PG8_BAR;
        PG8_WAIT_V(2); PG8_BAR;
        PG8_STAGE(PG8_SB(1, 0), cB + kstep, voffB); PG8_STAGE(PG8_SA(1, 0), cA + kstep, voffA); PG8_STAGE(PG8_SB(1, 1), cB + hstep + kstep, voffB);
        PG8_WAIT_V(6); PG8_BAR;
    } else {
        PG8_STAGE(PG8_SB(0, 0), cB, voffB); PG8_STAGE(PG8_SA(0, 0), cA, voffA); PG8_STAGE(PG8_SB(0, 1), cB + hstep, voffB); PG8_STAGE(PG8_SA(0, 1), cA + hstep, voffA);
        if (wr == 1) PG8_BAR;
        PG8_WAIT_V(4); PG8_BAR;
        PG8_STAGE(PG8_SB(1, 0), cB + kstep, voffB); PG8_STAGE(PG8_SA(1, 0), cA + kstep, voffA); PG8_STAGE(PG8_SB(1, 1), cB + hstep + kstep, voffB);
        PG8_WAIT_V(6); PG8_BAR;
    }
    for (;;) {
        const bool has_next = S.next(ui + 1, nxt);
        const char* nA = has_next ? (const char*)g.A + (size_t)nxt.pm * tstep : cA; const char* nB = has_next ? (const char*)g.Bt + (size_t)nxt.pn * tstep : cB;
        for (int t = 0; t < nt; t += 2) {
            const bool last = (t == nt - 2);
            const char* a1 = cA + (size_t)(t + 1) * kstep;
            const char* a2 = last ? nA : cA + (size_t)(t + 2) * kstep; const char* b2 = last ? nB : cB + (size_t)(t + 2) * kstep;
            const char* a3 = a2 + kstep; const char* b3 = b2 + kstep;
            if (last && has_next) S.a_ready(nxt);
            if constexpr (SP2) {
            PG8_LDB(B0, 0, 0); PG8_LDB(B1, 0, 1); PG8_SCHED; PG8_LDA(At, 0, 0); PG8_STAGE(PG8_SA(1, 1), a1 + hstep, voffA);
            PG8_WAIT_V(8); PG8_WAIT_L(0); PG8_BAR; PG8_MMA(0, 0, At, B0); PG8_MMA(0, 1, At, B1); PG8_BAR; PG8_SCHED;
            PG8_LDA(At, 0, 1); PG8_STAGE(PG8_SB(0, 0), b2, voffB); PG8_STAGE(PG8_SB(0, 1), b2 + hstep, voffB); PG8_STAGE(PG8_SA(0, 0), a2, voffA);
            PG8_WAIT_V(8); PG8_WAIT_L(0); PG8_BAR; PG8_MMA(1, 0, At, B0); PG8_MMA(1, 1, At, B1); PG8_BAR; PG8_SCHED;
            PG8_LDB(B0, 1, 0); PG8_LDB(B1, 1, 1); PG8_SCHED; PG8_LDA(At, 1, 0); PG8_STAGE(PG8_SA(0, 1), a2 + hstep, voffA);
            PG8_WAIT_V(8); PG8_WAIT_L(0); PG8_BAR; PG8_MMA(0, 0, At, B0); PG8_MMA(0, 1, At, B1); PG8_BAR; PG8_SCHED;
            PG8_LDA(At, 1, 1); PG8_STAGE(PG8_SB(1, 0), b3, voffB); PG8_STAGE(PG8_SB(1, 1), b3 + hstep, voffB); PG8_STAGE(PG8_SA(1, 0), a3, voffA);
            PG8_WAIT_V(8); PG8_WAIT_L(0); PG8_BAR; PG8_MMA(1, 0, At, B0); PG8_MMA(1, 1, At, B1); PG8_BAR; PG8_SCHED;
            } else {
            PG8_LDB(B0, 0, 0); PG8_SCHED; PG8_LDA(At, 0, 0); PG8_STAGE(PG8_SA(1, 1), a1 + hstep, voffA);
            PG8_WAIT_L(8); PG8_BAR; PG8_WAIT_L(0); PG8_MMA(0, 0, At, B0); PG8_BAR; PG8_SCHED;
            PG8_LDB(B1, 0, 1); PG8_STAGE(PG8_SB(0, 0), b2, voffB);
            PG8_BAR; PG8_WAIT_L(0); PG8_MMA(0, 1, At, B1); PG8_BAR;
            PG8_LDA(At, 0, 1); PG8_STAGE(PG8_SA(0, 0), a2, voffA);
            PG8_BAR; PG8_WAIT_L(0); PG8_MMA(1, 0, At, B0); PG8_BAR; PG8_SCHED;
            PG8_STAGE(PG8_SB(0, 1), b2 + hstep, voffB);
            PG8_WAIT_V(6); PG8_BAR; PG8_MMA(1, 1, At, B1); PG8_BAR;
            PG8_LDB(B0, 1, 0); PG8_SCHED; PG8_LDA(At, 1, 0); PG8_STAGE(PG8_SA(0, 1), a2 + hstep, voffA);
            PG8_WAIT_L(8); PG8_BAR; PG8_WAIT_L(0); PG8_MMA(0, 0, At, B0); PG8_BAR; PG8_SCHED;
            PG8_LDB(B1, 1, 1); PG8_STAGE(PG8_SB(1, 0), b3, voffB);
            PG8_BAR; PG8_WAIT_L(0); PG8_MMA(0, 1, At, B1); PG8_BAR;
            PG8_LDA(At, 1, 1); PG8_STAGE(PG8_SA(1, 0), a3, voffA);
            PG8_BAR; PG8_WAIT_L(0); PG8_MMA(1, 0, At, B0); PG8_BAR; PG8_SCHED;
            PG8_STAGE(PG8_SB(1, 1), b3 + hstep, voffB);
            PG8_WAIT_V(6); PG8_BAR; PG8_MMA(1, 1, At, B1); PG8_BAR;
            }
        }
        if constexpr (ALIGN_EPI) { if (wr == 0) PG8_BAR; }
        if constexpr (!Epi::AFTER_DRAIN) { E(acc, cur, wr, wc, fr, fq); S.done(cur); }
        if (!has_next) break;
#pragma unroll
        for (int a = 0; a < 2; ++a)
#pragma unroll
            for (int b = 0; b < 2; ++b)
#pragma unroll
                for (int m = 0; m < 4; ++m)
#pragma unroll
                    for (int n = 0; n < 2; ++n) acc[a][b][m][n] = (f32x4){0.f, 0.f, 0.f, 0.f};
        cur = nxt; cA = nA; cB = nB; ++ui;
        if constexpr (ALIGN_EPI) { if (wr == 1) PG8_BAR; }
    }
    PG8_WAIT_V(0);
    if constexpr (!ALIGN_EPI) { if (wr == 0) PG8_BAR; }
    PG8_BAR;
    if constexpr (Epi::AFTER_DRAIN) { E.fused(acc, cur, wr, wc, fr, fq, lds, wid, lane); S.done(cur); }
#undef PG8_SA
#undef PG8_SB
#undef PG8_STAGE
#undef PG8_LDA
#undef PG8_LDB
#undef PG8_MMA
#undef PG8_WAIT_V
#undef PG8_WAIT_L
#undef PG8_BAR
#undef PG8_SCHED
}
}

#define GAS __attribute__((address_space(1)))
#define LAS __attribute__((address_space(3)))
typedef unsigned short bf16;
typedef unsigned v4u __attribute__((ext_vector_type(4)));
typedef float f32x4 __attribute__((ext_vector_type(4)));
typedef short bf16x8 __attribute__((ext_vector_type(8)));
typedef GAS unsigned gu32;
typedef GAS unsigned long long gu64;
#define RLX_AGENT __ATOMIC_RELAXED, __HIP_MEMORY_SCOPE_AGENT
#define LDS_WAIT() asm volatile("s_waitcnt lgkmcnt(0)" ::: "memory")
#define VM_WAIT() asm volatile("s_waitcnt vmcnt(0)" ::: "memory")
__device__ __forceinline__ unsigned long long rt() { return __builtin_amdgcn_s_memrealtime(); }
__device__ __forceinline__ unsigned f2bf(float f) { unsigned u = __builtin_bit_cast(unsigned, f); return (u + 0x7fffu + ((u >> 16) & 1u)) >> 16; }
__device__ __forceinline__ unsigned pk2(float lo, float hi) { return f2bf(lo) | (f2bf(hi) << 16); }
#define XB_TMO      128
#define XB_XCNT(j)  (256  + 64 * (j))
#define XB_XSUB(j)  (1280 + 64 * (j))
#define XB_XGEN(j)  (2304 + 64 * (j))
#define XB_TOP      3328
#define XB_TOPGEN   3392
#define XCD_BAR_WORDS 3456
#define XB_SPIN_CAP (1u << 18)

__device__ __forceinline__ unsigned xb_ld(unsigned* p)              { return __hip_atomic_load(p, __ATOMIC_RELAXED, __HIP_MEMORY_SCOPE_AGENT); }
__device__ __forceinline__ unsigned xb_add(unsigned* p, unsigned v) { return __hip_atomic_fetch_add(p, v, __ATOMIC_RELAXED, __HIP_MEMORY_SCOPE_AGENT); }
__device__ __forceinline__ unsigned xb_xcc_id() { return (unsigned)__builtin_amdgcn_s_getreg((3 << 11) | 20) & 0xFu; }
#define XB_SPIN(cond, bar) do { unsigned _sp = 0; while (cond) { __builtin_amdgcn_s_sleep(1); \
    if ((++_sp & 255u) == 0u) { if (xb_ld(&(bar)[XB_TMO])) break; if (_sp > XB_SPIN_CAP) { atomicAdd(&(bar)[XB_TMO], 1u); break; } } } } while (0)

struct XcdBarrier {
    unsigned* bar; unsigned x;
    volatile LAS unsigned* st;
};

__device__ __forceinline__ XcdBarrier xcd_barrier_post(unsigned* bar, volatile LAS unsigned* st) {
    XcdBarrier b; b.bar = bar; b.x = (unsigned)__builtin_amdgcn_readfirstlane((int)xb_xcc_id()); b.st = st;
    if (threadIdx.x == 0) (void)xb_add(&bar[XB_XCNT(b.x)], 1u);
    return b;
}
__device__ __forceinline__ void xcd_barrier_complete(unsigned* bar, unsigned x, unsigned& nloc, unsigned& nx) {
    const unsigned G = gridDim.x * gridDim.y * gridDim.z;
    unsigned sum, cnt, mine, sp = 0u;
    for (;;) {
        sum = 0u; cnt = 0u; mine = 0u;
#pragma unroll
        for (unsigned j = 0; j < 16; ++j) { const unsigned c = xb_ld(&bar[XB_XCNT(j)]); sum += c; cnt += (c > 0u) ? 1u : 0u; mine = (j == x) ? c : mine; }
        if (sum == G) break;
        __builtin_amdgcn_s_sleep(1);
        if ((++sp & 255u) == 0u) { if (xb_ld(&bar[XB_TMO])) break; if (sp > XB_SPIN_CAP) { atomicAdd(&bar[XB_TMO], 1u); break; } }
    }
    nloc = mine > 0u ? mine : 1u; nx = cnt > 0u ? cnt : 1u;
}

__device__ __forceinline__ void xcd_barrier(const XcdBarrier& b) {
    asm volatile("s_waitcnt vmcnt(0)" ::: "memory");
    __syncthreads();
    if (threadIdx.x == 0) {
        unsigned* bar = b.bar; asm volatile("" : "+s"(bar));
        __builtin_amdgcn_s_waitcnt(0);
        unsigned nloc = b.st[0], nx = b.st[1];
        if (nloc == 0u) { xcd_barrier_complete(bar, b.x, nloc, nx); b.st[0] = nloc; b.st[1] = nx; }
        const unsigned old = xb_add(&bar[XB_XSUB(b.x)], 1u);
        const unsigned gen = old / nloc;
        if (old + 1u == (gen + 1u) * nloc) {
            __builtin_amdgcn_fence(__ATOMIC_RELEASE, "agent");
            asm volatile("s_waitcnt vmcnt(0)" ::: "memory");
            const unsigned og = xb_add(&bar[XB_TOP], 1u);
            const unsigned tg = og / nx;
            if (og + 1u == (tg + 1u) * nx) xb_add(&bar[XB_TOPGEN], 1u);
            else XB_SPIN(xb_ld(&bar[XB_TOPGEN]) == tg, bar);
            __builtin_amdgcn_fence(__ATOMIC_ACQUIRE, "agent");
            xb_add(&bar[XB_XGEN(b.x)], 1u);
            asm volatile("s_waitcnt vmcnt(0)" ::: "memory");
        } else {
            XB_SPIN(xb_ld(&bar[XB_XGEN(b.x)]) == gen, bar);
            __builtin_amdgcn_fence(__ATOMIC_ACQUIRE, "agent");
            asm volatile("s_waitcnt vmcnt(0)" ::: "memory");
        }
    }
    __syncthreads();
}

constexpr int RING_OFF = 0, RING_BYTES = 131072;
constexpr int LDSCTL_OFF = RING_BYTES, MISC_OFF = LDSCTL_OFF + 320;
constexpr int LDS_BYTES = 147456;
constexpr size_t CTL_ZERO_BYTES = 64 * 1024;
constexpr int CW_BAR = 1024;

struct Params {
    const float *x, *c, *ctx, *c_ctx, *w_ada, *b_ada, *norm_g, *w_in, *conv_w, *conv_b, *gate_b, *sink, *head_g, *w_out, *final_g;
    float* out;
    unsigned* ctl;
    h16 *P, *XN, *CQK, *WIN_T, *WOUT_T;
    float *XC, *GATES, *MOD, *ROPE;
};

__device__ __forceinline__ float silu_f(float x) { return x * __builtin_amdgcn_rcpf(1.f + __builtin_amdgcn_exp2f(-1.4426950408889634f * x)); }
__device__ __forceinline__ float sigmoid_f(float x) { return __builtin_amdgcn_rcpf(1.f + __builtin_amdgcn_exp2f(-1.4426950408889634f * x)); }
__device__ __forceinline__ float wave_sum(float v) {
#pragma unroll
    for (int o = 1; o < 64; o <<= 1) v += __shfl_xor(v, o);
    return v;
}

__device__ __forceinline__ void transpose_item(const float* W, int K, int N, int Npad, h16* WT, LAS float* scr, int item, int lane) {
    const int nblk = Npad / 32, kb = item / nblk, nb = item % nblk, k0 = 64 * kb, n0 = 32 * nb;
#pragma unroll 8
    for (int i = 0; i < 32; ++i) { const int kk = 2 * i + (lane >> 5); const int n = n0 + (lane & 31); scr[kk * 33 + (lane & 31)] = n < N ? W[(size_t)(k0 + kk) * N + n] : 0.f; }
    LDS_WAIT(); asm volatile("" ::: "memory");
    const int c = lane & 7;
#pragma unroll
    for (int j = 0; j < 4; ++j) { const int n = (lane >> 3) + 8 * j; const LAS float* s = scr + (8 * c) * 33 + n;
        v4u o; o.x = pkh(s[0 * 33], s[1 * 33]); o.y = pkh(s[2 * 33], s[3 * 33]); o.z = pkh(s[4 * 33], s[5 * 33]); o.w = pkh(s[6 * 33], s[7 * 33]);
        *(GAS v4u*)(WT + (size_t)(n0 + n) * K + k0 + 8 * c) = o; }
    LDS_WAIT(); asm volatile("" ::: "memory");
}


typedef short v4i16_t __attribute__((ext_vector_type(4)));
typedef _Float16 h16x4 __attribute__((ext_vector_type(4)));
typedef _Float16 h16x8 __attribute__((ext_vector_type(8)));
constexpr int AT_RB = 128, AT_TILE = 64 * AT_RB;
constexpr float AT_SC = 0.18033688011112042f, LOG2E = 1.4426950408889634f;
__device__ __forceinline__ h16x4 tr16(LAS unsigned char* p) { return __builtin_bit_cast(h16x4, __builtin_amdgcn_ds_read_tr16_b64_v4i16((LAS v4i16_t*)p)); }
__device__ __forceinline__ void attn_phase(LAS unsigned char* lds, const h16* __restrict__ P, const float* __restrict__ sink, h16* __restrict__ MIX, int bid, int G, int nitems) {
    int tid = threadIdx.x; asm volatile("" : "+v"(tid));
    const int lane = tid & 63, wave = __builtin_amdgcn_readfirstlane(tid >> 6), l15 = lane & 15, g = lane >> 4;
    const int srow = tid >> 3, sseg = tid & 7;
    for (int it = bid; it < nitems; it += G) {
        int b, hkv, n, qrow0, nch; bool isctx;
        if (it < 256) { b = it >> 5; hkv = (it >> 4) & 1; n = it & 15; qrow0 = b * T + n * 128; nch = (n == 0 || n == 15) ? 8 : 10; isctx = false; }
        else { const int j = it - 256; b = j >> 2; hkv = (j >> 1) & 1; n = j & 1; qrow0 = NLAT + b * LC + n * 128; nch = 4; isctx = true; }
        const int hq = hkv * 4 + (wave >> 1), iq0 = (wave & 1) * 64;
#define AT_CI(k) (isctx ? (k) + 6 : (k) + ((n == 0 || (n == 15 && (k) >= 4)) ? 2 : 0))
#define AT_ROW(ci) ((ci) < 6 ? b * T + (n - 1) * 128 + (ci) * 64 : NLAT + b * LC + ((ci) - 6) * 64)
        h16x8 qf[4][2];
#pragma unroll
        for (int qt = 0; qt < 4; ++qt) { const h16* qp = P + (size_t)(qrow0 + iq0 + qt * 16 + l15) * PW + C_AQ + hq * 64 + g * 8; qf[qt][0] = *(const h16x8*)qp; qf[qt][1] = *(const h16x8*)(qp + 32); }
        float m[4], lsum[4]; f32x4 O[4][4];
        const float sinkv = sink[hq] * LOG2E;
#pragma unroll
        for (int qt = 0; qt < 4; ++qt) { m[qt] = sinkv; lsum[qt] = (g == 0) ? 1.f : 0.f;
#pragma unroll
            for (int dt = 0; dt < 4; ++dt) O[dt][qt] = (f32x4){0.f, 0.f, 0.f, 0.f}; }
        const int sswz = (sseg ^ ((srow >> 1) & 7)) * 8;
#define AT_STAGE(ci_, buf_) do { const size_t r_ = (size_t)(AT_ROW(ci_) + srow); \
            __builtin_amdgcn_global_load_lds((const unsigned*)(P + r_ * PW + C_AK + hkv * 64 + sswz), (LAS unsigned*)(lds + (buf_) * AT_TILE + wave * 1024), 16, 0, 0); \
            __builtin_amdgcn_global_load_lds((const unsigned*)(P + r_ * PW + C_AV + hkv * 64 + sswz), (LAS unsigned*)(lds + (2 + (buf_)) * AT_TILE + wave * 1024), 16, 0, 0); } while (0)
        { const int ci0 = AT_CI(0); AT_STAGE(ci0, 0); }
        __syncthreads();
        for (int k = 0; k < nch; ++k) {
            const int cur = k & 1, ci = AT_CI(k);
            if (k + 1 < nch) { const int c2 = AT_CI(k + 1); AT_STAGE(c2, cur ^ 1); }
            LAS unsigned char* Kb = lds + cur * AT_TILE; LAS unsigned char* Vb = lds + (2 + cur) * AT_TILE;
            const int mtype = (ci < 2) ? 1 : ((ci == 4 || ci == 5) ? 2 : 0);
#pragma unroll 1
            for (int sub = 0; sub < 2; ++sub) {
                f32x4 s[2][4];
#pragma unroll
                for (int t = 0; t < 2; ++t) { const int kr = sub * 32 + t * 16 + l15, ksw = (kr >> 1) & 7; const LAS unsigned char* kp = Kb + kr * AT_RB;
                    const h16x8 kf0 = *(const LAS h16x8*)(kp + ((g ^ ksw) << 4)), kf1 = *(const LAS h16x8*)(kp + (((4 + g) ^ ksw) << 4));
#pragma unroll
                    for (int qt = 0; qt < 4; ++qt) { f32x4 z = (f32x4){0.f, 0.f, 0.f, 0.f}; z = __builtin_amdgcn_mfma_f32_16x16x32_f16(kf0, qf[qt][0], z, 0, 0, 0); s[t][qt] = __builtin_amdgcn_mfma_f32_16x16x32_f16(kf1, qf[qt][1], z, 0, 0, 0); } }
#pragma unroll
                for (int t = 0; t < 2; ++t)
#pragma unroll
                    for (int qt = 0; qt < 4; ++qt)
#pragma unroll
                        for (int r = 0; r < 4; ++r) { float v = s[t][qt][r] * AT_SC;
                            if (mtype) { const int jk = ci * 64 + sub * 32 + t * 16 + 4 * g + r, iq = iq0 + qt * 16 + l15; const bool ok = (mtype == 1) ? (jk >= iq) : (jk <= iq + 256); v = ok ? v : -INFINITY; }
                            s[t][qt][r] = v; }
                h16x8 pb[4];
#pragma unroll
                for (int qt = 0; qt < 4; ++qt) {
                    float mx = fmaxf(fmaxf(fmaxf(s[0][qt][0], s[0][qt][1]), fmaxf(s[0][qt][2], s[0][qt][3])), fmaxf(fmaxf(s[1][qt][0], s[1][qt][1]), fmaxf(s[1][qt][2], s[1][qt][3])));
                    mx = fmaxf(mx, __shfl_xor(mx, 16)); mx = fmaxf(mx, __shfl_xor(mx, 32));
                    const float mn = fmaxf(m[qt], mx); const float f = __builtin_amdgcn_exp2f(m[qt] - mn); m[qt] = mn;
                    float ps = 0.f;
#pragma unroll
                    for (int t = 0; t < 2; ++t)
#pragma unroll
                        for (int r = 0; r < 4; ++r) { const float pe = __builtin_amdgcn_exp2f(s[t][qt][r] - mn); s[t][qt][r] = pe; ps += pe; }
                    lsum[qt] = lsum[qt] * f + ps;
#pragma unroll
                    for (int dt = 0; dt < 4; ++dt) O[dt][qt] = O[dt][qt] * f;
                    pb[qt] = (h16x8){(h16)s[0][qt][0], (h16)s[0][qt][1], (h16)s[0][qt][2], (h16)s[0][qt][3], (h16)s[1][qt][0], (h16)s[1][qt][1], (h16)s[1][qt][2], (h16)s[1][qt][3]};
                }
#pragma unroll
                for (int dt = 0; dt < 4; ++dt) { const int vr = sub * 32 + 4 * g + (l15 >> 2), vsw = (vr >> 1) & 7, vc = 2 * dt + ((l15 >> 1) & 1);
                    LAS unsigned char* vp = Vb + vr * AT_RB + ((vc ^ vsw) << 4) + (l15 & 1) * 8;
                    const h16x4 lo = tr16(vp), hi = tr16(vp + 16 * AT_RB);
                    const h16x8 va = __builtin_shufflevector(lo, hi, 0, 1, 2, 3, 4, 5, 6, 7);
#pragma unroll
                    for (int qt = 0; qt < 4; ++qt) O[dt][qt] = __builtin_amdgcn_mfma_f32_16x16x32_f16(va, pb[qt], O[dt][qt], 0, 0, 0); }
            }
            __syncthreads();
        }
#pragma unroll
        for (int qt = 0; qt < 4; ++qt) { float lt = lsum[qt]; lt += __shfl_xor(lt, 16); lt += __shfl_xor(lt, 32); const float inv = 1.f / lt;
            const size_t qrow = (size_t)(qrow0 + iq0 + qt * 16 + l15);
#pragma unroll
            for (int dt = 0; dt < 4; ++dt) { const int d0 = dt * 16 + 4 * g;
                const h16x4 az = *(const h16x4*)(P + qrow * PW + C_AZ + hq * 64 + d0);
                const f32x4 o = O[dt][qt] * inv;
                uint2 w; w.x = pkh(o[0] * silu_f((float)az[0]), o[1] * silu_f((float)az[1])); w.y = pkh(o[2] * silu_f((float)az[2]), o[3] * silu_f((float)az[3]));
                *(uint2*)(MIX + qrow * D + hq * 64 + d0) = w; } }
#undef AT_CI
#undef AT_ROW
#undef AT_STAGE
    }
}


constexpr int ML_RS = 272;
constexpr int ML_QS = 0, ML_KS = 34816, ML_VS = 69632, ML_WV = 86016, ML_C16 = 102400, ML_NV = 119808, ML_RED = 120320, ML_SC = 122368, ML_SCB = 2816;
constexpr float ML_KSC = 0.08838834764831845f;
__device__ __forceinline__ int ml_row(int dir, int b, int p) { if (p < LC) { const int tc = dir ? LC - 1 - p : p; return NLAT + b * LC + tc; } const int pl = p - LC; const int tq = dir ? T - 1 - pl : pl; return b * T + tq; }
__device__ __forceinline__ float ml_prep(LAS unsigned char* sc, float i0, float i1, float f0, float f1, float m, int lane) {
    const float lf0 = fminf(f0, 0.f) - log1pf(expf(-fabsf(f0))), lf1 = fminf(f1, 0.f) - log1pf(expf(-fabsf(f1)));
    const float c = lf0 + lf1; float x = c;
#pragma unroll
    for (int off = 1; off < 64; off <<= 1) { const float tv = __shfl_up(x, off); if (lane >= off) x += tv; }
    const float excl = x - c, b0 = excl + lf0, b1 = excl + c;
    const float u0 = i0 - b0, u1 = i1 - b1;
    float y = fmaxf(u0, u1);
#pragma unroll
    for (int off = 1; off < 64; off <<= 1) { const float tv = __shfl_up(y, off); if (lane >= off) y = fmaxf(y, tv); }
    float exm = __shfl_up(y, 1); if (lane == 0) exm = -INFINITY;
    const float pm0 = fmaxf(exm, u0), pm1 = fmaxf(pm0, u1);
    const float M0 = fmaxf(m, pm0), M1 = fmaxf(m, pm1);
    const float Ml = __shfl(M1, 63), bL = __shfl(b1, 63);
    LAS float* f = (LAS float*)sc;
    f[2 * lane] = u0 * LOG2E; f[2 * lane + 1] = u1 * LOG2E;
    f[128 + 2 * lane] = M0 * LOG2E; f[128 + 2 * lane + 1] = M1 * LOG2E;
    f[256 + 2 * lane] = expf(m - M0); f[256 + 2 * lane + 1] = expf(m - M1);
    f[384 + 2 * lane] = expf(-(b0 + M0)); f[384 + 2 * lane + 1] = expf(-(b1 + M1));
    f[512 + 2 * lane] = expf(u0 - Ml); f[512 + 2 * lane + 1] = expf(u1 - Ml);
    if (lane == 0) f[640] = expf(m - Ml);
    return bL + Ml;
}
__device__ __forceinline__ void mlstm_item(LAS unsigned char* lds, h16* __restrict__ P, const h16* __restrict__ CQK, const float* __restrict__ GATES, int item) {
    int tid = threadIdx.x; asm volatile("" : "+v"(tid));
    const int lane = tid & 63, wave = __builtin_amdgcn_readfirstlane(tid >> 6), l15 = lane & 15, g = lane >> 4;
    const int slice = item & 1, chain = item >> 1, head = chain & 3, b = (chain >> 2) & 7, dir = chain >> 5;
    const int tt = wave < 4 ? wave : 11 - wave;
    h16* Hdst = P + (dir ? C_MK : C_MQ) + head * 128 + slice * 64;
    v4u rq[4], rk[4], rv[2]; float gi0 = 0.f, gi1 = 0.f, gf0 = 0.f, gf1 = 0.f; float mstate = -INFINITY;
#define ML_LOAD(kk) do { _Pragma("unroll") for (int i_ = 0; i_ < 4; ++i_) { const int e_ = tid + 512 * i_, r_ = e_ >> 4, c_ = e_ & 15; const size_t gr_ = (size_t)ml_row(dir, b, (kk) * 128 + r_); \
            rq[i_] = *(const v4u*)(CQK + gr_ * 1024 + head * 128 + c_ * 8); rk[i_] = *(const v4u*)(CQK + gr_ * 1024 + 512 + head * 128 + c_ * 8); } \
        _Pragma("unroll") for (int i_ = 0; i_ < 2; ++i_) { const int e_ = tid + 512 * i_, r_ = e_ >> 3, c_ = e_ & 7; const size_t gr_ = (size_t)ml_row(dir, b, (kk) * 128 + r_); \
            rv[i_] = *(const v4u*)(P + gr_ * PW + C_MV + head * 128 + slice * 64 + c_ * 8); } \
        if (wave == 0) { const size_t g0_ = (size_t)ml_row(dir, b, (kk) * 128 + 2 * lane), g1_ = (size_t)ml_row(dir, b, (kk) * 128 + 2 * lane + 1); \
            gi0 = GATES[g0_ * 16 + dir * 4 + head]; gi1 = GATES[g1_ * 16 + dir * 4 + head]; gf0 = GATES[g0_ * 16 + 8 + dir * 4 + head]; gf1 = GATES[g1_ * 16 + 8 + dir * 4 + head]; } } while (0)
#define ML_STORE(scb) do { const LAS float* ws_ = (const LAS float*)(lds + ML_SC + (scb) * ML_SCB) + 512; \
        _Pragma("unroll") for (int i_ = 0; i_ < 4; ++i_) { const int e_ = tid + 512 * i_, r_ = e_ >> 4, c_ = e_ & 15; \
            *(LAS v4u*)(lds + ML_QS + r_ * ML_RS + c_ * 16) = rq[i_]; *(LAS v4u*)(lds + ML_KS + r_ * ML_RS + c_ * 16) = rk[i_]; } \
        _Pragma("unroll") for (int i_ = 0; i_ < 2; ++i_) { const int e_ = tid + 512 * i_, r_ = e_ >> 3, c_ = e_ & 7; const int o_ = r_ * 128 + ((c_ ^ ((r_ >> 1) & 7)) << 4); \
            *(LAS v4u*)(lds + ML_VS + o_) = rv[i_]; const float w_ = ws_[r_]; const h16x8 hv_ = __builtin_bit_cast(h16x8, rv[i_]); h16x8 hw_; \
            _Pragma("unroll") for (int j_ = 0; j_ < 8; ++j_) hw_[j_] = (h16)((float)hv_[j_] * w_); \
            *(LAS h16x8*)(lds + ML_WV + o_) = hw_; } } while (0)
    ML_LOAD(0);
    for (int i = tid; i < (64 * ML_RS + 512) / 4; i += NTHR) ((LAS unsigned*)(lds + ML_C16))[i] = 0u;
    if (wave == 0) mstate = ml_prep(lds + ML_SC, gi0, gi1, gf0, gf1, mstate, lane);
    f32x4 CA[4];
#pragma unroll
    for (int vi = 0; vi < 4; ++vi) CA[vi] = (f32x4){0.f, 0.f, 0.f, 0.f};
    __syncthreads();
    ML_STORE(0);
    __syncthreads();
    for (int k = 0; k < 18; ++k) {
        LAS unsigned char* sc = lds + ML_SC + (k & 1) * ML_SCB;
        const LAS float* scf = (const LAS float*)sc;
        if (k < 17) ML_LOAD(k + 1);
        {
            h16x8 qf[4];
#pragma unroll
            for (int ks = 0; ks < 4; ++ks) qf[ks] = *(const LAS h16x8*)(lds + ML_QS + (16 * tt + l15) * ML_RS + (32 * ks + 8 * g) * 2);
            f32x4 sT[8];
#pragma unroll
            for (int si = 0; si < 8; ++si) { sT[si] = (f32x4){0.f, 0.f, 0.f, 0.f};
                if (si <= tt) {
#pragma unroll
                    for (int ks = 0; ks < 4; ++ks) { const h16x8 kf = *(const LAS h16x8*)(lds + ML_KS + (16 * si + l15) * ML_RS + (32 * ks + 8 * g) * 2); sT[si] = __builtin_amdgcn_mfma_f32_16x16x32_f16(kf, qf[ks], sT[si], 0, 0, 0); } } }
            const float M2t = scf[128 + 16 * tt + l15], wi = scf[256 + 16 * tt + l15], em = scf[384 + 16 * tt + l15];
            float rs = 0.f;
#pragma unroll
            for (int si = 0; si < 8; ++si) if (si <= tt) { const f32x4 u4 = *(const LAS f32x4*)(scf + 16 * si + 4 * g);
#pragma unroll
                for (int r = 0; r < 4; ++r) { float pe = sT[si][r] * ML_KSC * __builtin_amdgcn_exp2f(u4[r] - M2t); if (si == tt && (4 * g + r) > l15) pe = 0.f; sT[si][r] = pe; rs += pe; } }
            rs += __shfl_xor(rs, 16); rs += __shfl_xor(rs, 32);
            f32x4 NT[4];
#pragma unroll
            for (int vi = 0; vi < 4; ++vi) { f32x4 z = (f32x4){0.f, 0.f, 0.f, 0.f};
#pragma unroll
                for (int ks = 0; ks < 4; ++ks) { const h16x8 cf = *(const LAS h16x8*)(lds + ML_C16 + (16 * vi + l15) * ML_RS + (32 * ks + 8 * g) * 2); z = __builtin_amdgcn_mfma_f32_16x16x32_f16(cf, qf[ks], z, 0, 0, 0); }
                NT[vi] = z * wi; }
            float nq = 0.f;
#pragma unroll
            for (int ks = 0; ks < 4; ++ks) { const f32x4 n0 = *(const LAS f32x4*)(lds + ML_NV + (32 * ks + 8 * g) * 4), n1 = *(const LAS f32x4*)(lds + ML_NV + (32 * ks + 8 * g + 4) * 4);
                nq += n0[0] * (float)qf[ks][0] + n0[1] * (float)qf[ks][1] + n0[2] * (float)qf[ks][2] + n0[3] * (float)qf[ks][3] + n1[0] * (float)qf[ks][4] + n1[1] * (float)qf[ks][5] + n1[2] * (float)qf[ks][6] + n1[3] * (float)qf[ks][7]; }
            nq += __shfl_xor(nq, 16); nq += __shfl_xor(nq, 32); nq *= ML_KSC;
#pragma unroll
            for (int sg = 0; sg < 4; ++sg) if (2 * sg <= tt) {
                const h16x8 pb = (h16x8){(h16)sT[2 * sg][0], (h16)sT[2 * sg][1], (h16)sT[2 * sg][2], (h16)sT[2 * sg][3], (h16)sT[2 * sg + 1][0], (h16)sT[2 * sg + 1][1], (h16)sT[2 * sg + 1][2], (h16)sT[2 * sg + 1][3]};
#pragma unroll
                for (int vi = 0; vi < 4; ++vi) { const int vr = 32 * sg + 4 * g + (l15 >> 2), vc = 2 * vi + ((l15 >> 1) & 1);
                    LAS unsigned char* vp = lds + ML_VS + vr * 128 + ((vc ^ ((vr >> 1) & 7)) << 4) + (l15 & 1) * 8;
                    const h16x4 lo = tr16(vp), hi = tr16(vp + 16 * 128);
                    NT[vi] = __builtin_amdgcn_mfma_f32_16x16x32_f16(__builtin_shufflevector(lo, hi, 0, 1, 2, 3, 4, 5, 6, 7), pb, NT[vi], 0, 0, 0); } }
            const float den = wi * nq + rs; const float inv = 1.0f / fmaxf(fabsf(den), em);
            h16* hp = Hdst + (size_t)ml_row(dir, b, k * 128 + 16 * tt + l15) * PW + 4 * g;
#pragma unroll
            for (int vi = 0; vi < 4; ++vi) { const f32x4 o = NT[vi] * inv; uint2 w; w.x = pkh(o[0], o[1]); w.y = pkh(o[2], o[3]); *(uint2*)(hp + 16 * vi) = w; }
            { const int d = tid & 127, sq = tid >> 7; float part = 0.f;
#pragma unroll 8
              for (int s2 = 0; s2 < 32; ++s2) { const int s = 32 * sq + s2; part += scf[512 + s] * (float)*(const LAS h16*)(lds + ML_KS + s * ML_RS + d * 2); }
              ((LAS float*)(lds + ML_RED))[sq * 128 + d] = part; }
        }
        __syncthreads();
        {
            const float a = scf[640];
            if (k < 17) {
#pragma unroll
                for (int vi = 0; vi < 4; ++vi) CA[vi] = CA[vi] * a;
#pragma unroll
                for (int sg = 0; sg < 4; ++sg) {
                    LAS unsigned char* kp = lds + ML_KS + (32 * sg + 4 * g + (l15 >> 2)) * ML_RS + (16 * wave + 4 * (l15 & 3)) * 2;
                    const h16x4 klo = tr16(kp), khi = tr16(kp + 16 * ML_RS);
                    const h16x8 kb = __builtin_shufflevector(klo, khi, 0, 1, 2, 3, 4, 5, 6, 7);
#pragma unroll
                    for (int vi = 0; vi < 4; ++vi) { const int vr = 32 * sg + 4 * g + (l15 >> 2), vc = 2 * vi + ((l15 >> 1) & 1);
                        LAS unsigned char* vp = lds + ML_WV + vr * 128 + ((vc ^ ((vr >> 1) & 7)) << 4) + (l15 & 1) * 8;
                        const h16x4 lo = tr16(vp), hi = tr16(vp + 16 * 128);
                        CA[vi] = __builtin_amdgcn_mfma_f32_16x16x32_f16(__builtin_shufflevector(lo, hi, 0, 1, 2, 3, 4, 5, 6, 7), kb, CA[vi], 0, 0, 0); } }
#pragma unroll
                for (int vi = 0; vi < 4; ++vi)
#pragma unroll
                    for (int r = 0; r < 4; ++r) *(LAS h16*)(lds + ML_C16 + (16 * vi + 4 * g + r) * ML_RS + (16 * wave + l15) * 2) = (h16)(CA[vi][r] * ML_KSC);
                if (tid < 128) { LAS float* nv = (LAS float*)(lds + ML_NV); const LAS float* red = (const LAS float*)(lds + ML_RED); nv[tid] = a * nv[tid] + ((red[tid] + red[128 + tid]) + (red[256 + tid] + red[384 + tid])); }
                if (wave == 0) mstate = ml_prep(lds + ML_SC + ((k + 1) & 1) * ML_SCB, gi0, gi1, gf0, gf1, mstate, lane);
            }
        }
        __syncthreads();
        if (k < 17) ML_STORE((k + 1) & 1);
        __syncthreads();
    }
#undef ML_LOAD
#undef ML_STORE
}

__global__ void __launch_bounds__(NTHR, 2) fwd_megakernel(Params p) {
    extern __shared__ __attribute__((aligned(16))) unsigned char lds[];
    LAS unsigned char* ldsl = (LAS unsigned char*)lds;
    const int G = gridDim.x, bid = blockIdx.x, GT = G * NTHR, NGW = G * NWAVES;
#define PHASE_IDS() int tid = threadIdx.x; asm volatile("" : "+v"(tid)); const int lane = tid & 63, wave = __builtin_amdgcn_readfirstlane(tid >> 6); \
    const int gtid = bid * NTHR + tid, gw = bid * NWAVES + wave; (void)lane; (void)wave; (void)gtid; (void)gw
    for (int u = threadIdx.x; u < (LDS_BYTES - LDSCTL_OFF) / 4; u += NTHR) ((LAS unsigned*)(ldsl + LDSCTL_OFF))[u] = 0u;
    __syncthreads();
    volatile LAS unsigned* MISC = (volatile LAS unsigned*)(ldsl + MISC_OFF);
    XcdBarrier bar = xcd_barrier_post(p.ctl + CW_BAR, MISC + 8);
#ifdef PROBE_A
    unsigned long long tprev_ = __builtin_amdgcn_s_memrealtime(); unsigned long long pacc0 = 0, pacc1 = 0, pacc2 = 0, pacc3 = 0, pacc4 = 0, pacc5 = 0, pacc6 = 0, pacc7 = 0;
#define GRID_BAR_P(ph) do { xcd_barrier(bar); const unsigned long long tn_ = __builtin_amdgcn_s_memrealtime(); const unsigned long long d_ = tn_ - tprev_; tprev_ = tn_; \
        if ((ph) == 0) pacc0 += d_; else if ((ph) == 1) pacc1 += d_; else if ((ph) == 2) pacc2 += d_; else if ((ph) == 3) pacc3 += d_; else if ((ph) == 4) pacc4 += d_; else if ((ph) == 5) pacc5 += d_; else if ((ph) == 6) pacc6 += d_; else pacc7 += d_; } while (0)
#else
#define GRID_BAR_P(ph) xcd_barrier(bar)
#endif
#define GRID_BAR() xcd_barrier(bar)

    {
        PHASE_IDS();
        LAS float* sc = (LAS float*)ldsl;
        LAS float* red = sc + 9 * 1024;
        for (int i = tid; i < 9 * 1024; i += NTHR) { const int r = i >> 10, k = i & 1023; const float v = (r < 8) ? p.c[r * 1024 + k] : p.c_ctx[k]; sc[i] = silu_f(v); }
        __syncthreads();
        for (int it = bid; it < DEPTH * 48; it += G) {
            const int l = it / 48, j = (it % 48) * 64 + lane;
            const float* w = p.w_ada + (size_t)l * 1024 * 3072 + j;
            float a0 = 0, a1 = 0, a2 = 0, a3 = 0, a4 = 0, a5 = 0, a6 = 0, a7 = 0, a8 = 0;
            for (int kk = 0; kk < 128; ++kk) { const int k = wave * 128 + kk; const float wv = w[(size_t)k * 3072];
                a0 += sc[0 * 1024 + k] * wv; a1 += sc[1 * 1024 + k] * wv; a2 += sc[2 * 1024 + k] * wv; a3 += sc[3 * 1024 + k] * wv; a4 += sc[4 * 1024 + k] * wv;
                a5 += sc[5 * 1024 + k] * wv; a6 += sc[6 * 1024 + k] * wv; a7 += sc[7 * 1024 + k] * wv; a8 += sc[8 * 1024 + k] * wv; }
            LAS float* rw = red + wave * 9 * 64 + lane;
            rw[0 * 64] = a0; rw[1 * 64] = a1; rw[2 * 64] = a2; rw[3 * 64] = a3; rw[4 * 64] = a4; rw[5 * 64] = a5; rw[6 * 64] = a6; rw[7 * 64] = a7; rw[8 * 64] = a8;
            __syncthreads();
            for (int e = tid; e < 9 * 64; e += NTHR) { float s = 0.f;
#pragma unroll
                for (int w8 = 0; w8 < 8; ++w8) s += red[w8 * 9 * 64 + e];
                const int r = e >> 6, jj = (it % 48) * 64 + (e & 63);
                p.MOD[((size_t)l * 9 + r) * 3072 + jj] = s + p.b_ada[l * 3072 + jj]; }
            __syncthreads();
        }
    }
    {
        PHASE_IDS();
        LAS float* scr = (LAS float*)(ldsl + 57344 + wave * 8448);
        constexpr int I_IN = (D / 64) * (NWT / 32), I_OUT = (D / 64) * (D / 32), I_L = I_IN + I_OUT;
        for (int it = gw; it < DEPTH * I_L; it += NGW) { const int l = it / I_L, r = it % I_L;
            if (r < I_IN) transpose_item(p.w_in + (size_t)l * D * INC, D, INC, NWT, p.WIN_T + (size_t)l * NWT * D, scr, r, lane);
            else transpose_item(p.w_out + (size_t)l * D * D, D, D, D, p.WOUT_T + (size_t)l * D * D, scr, r - I_IN, lane); }
        if (gtid < 64 * 16) { const int pos = gtid >> 4, i = gtid & 15; const float inv = powf(10000.0f, -(float)i / 16.0f); const float ang = (float)pos * inv;
            p.ROPE[gtid * 2] = cosf(ang); p.ROPE[gtid * 2 + 1] = sinf(ang); }
    }
    GRID_BAR_P(0);

    for (int l = 0; l < DEPTH; ++l) {
        const bool last = (l == DEPTH - 1);
        const float* MODl = p.MOD + (size_t)l * 9 * 3072;
        const float* xin_lat = (l == 0) ? p.x : p.out; const float* xin_ctx = (l == 0) ? p.ctx : p.XC;

        for (int rep_ = 0; rep_ < ((DUP_PHASE == 1) ? 2 : 1); ++rep_) {
        {
            PHASE_IDS();
            const float* g = p.norm_g + l * D;
            for (int row0 = gw; row0 < NROW; row0 += 3 * NGW) {
                f32x4 v[3][4]; float ss[3];
#pragma unroll
                for (int q = 0; q < 3; ++q) { const int row = row0 + q * NGW; ss[q] = 0.f;
                    if (row < NROW) { const float* xr = row < NLAT ? xin_lat + (size_t)row * D : xin_ctx + (size_t)(row - NLAT) * D;
#pragma unroll
                        for (int j = 0; j < 4; ++j) v[q][j] = *(const f32x4*)(xr + (j * 64 + lane) * 4); }
                    else {
#pragma unroll
                        for (int j = 0; j < 4; ++j) v[q][j] = (f32x4){0.f, 0.f, 0.f, 0.f}; } }
#pragma unroll
                for (int q = 0; q < 3; ++q) {
#pragma unroll
                    for (int j = 0; j < 4; ++j) ss[q] += v[q][j].x * v[q][j].x + v[q][j].y * v[q][j].y + v[q][j].z * v[q][j].z + v[q][j].w * v[q][j].w;
                    ss[q] = wave_sum(ss[q]); }
#pragma unroll
                for (int q = 0; q < 3; ++q) { const int row = row0 + q * NGW;
                    if (row < NROW) { const int mr = row < NLAT ? (row >> 11) : 8; const float* shift = MODl + mr * 3072; const float* scale = shift + 1024;
                        const float rstd = 1.0f / sqrtf(ss[q] * (1.f / D) + EPS);
#pragma unroll
                        for (int j = 0; j < 4; ++j) { const int k = (j * 64 + lane) * 4;
                            const f32x4 gg = *(const f32x4*)(g + k), sc = *(const f32x4*)(scale + k), sh = *(const f32x4*)(shift + k);
                            const f32x4 o = v[q][j] * rstd * gg * (sc + 1.f) + sh;
                            uint2 w; w.x = pkh(o.x, o.y); w.y = pkh(o.z, o.w); *(uint2*)(p.XN + (size_t)row * D + k) = w; } } }
            }
        }
        GRID_BAR_P(1);
        }

        for (int rep_ = 0; rep_ < ((DUP_PHASE == 2) ? 2 : 1); ++rep_) {
        {
            const pg8::bf16_t* gA = (const pg8::bf16_t*)p.XN; const pg8::bf16_t* gB = (const pg8::bf16_t*)(p.WIN_T + (size_t)l * NWT * D); asm volatile("" : "+s"(gA), "+s"(gB));
            pg8::Gemm g{gA, gB, NROW, NPAD, D}; pg8::StaticOrder S; S.init(NROW, NPAD, G, bid);
            pg8::EpiProjH E{p.P, p.GATES, p.gate_b + l * 16, p.ROPE};
            pg8::gemm_phase<pg8::EpiProjH, pg8::StaticOrder, true, true>(ldsl + RING_OFF, g, S, E);
        }
        GRID_BAR_P(2);
        }

        for (int rep_ = 0; rep_ < ((DUP_PHASE == 3) ? 2 : 1); ++rep_) {
        {
            PHASE_IDS();
            const float* cw = p.conv_w + (size_t)l * 5 * 1024; const float* cb = p.conv_b + l * 1024;
            for (int un = gtid; un < (NROW / 16) * 128; un += GT) {
                const int cg = un & 127, run = un >> 7, r0 = run * 16, c = cg * 8;
                int t0, len; if (r0 < NLAT) { t0 = r0 & (T - 1); len = T; } else { t0 = (r0 - NLAT) & (LC - 1); len = LC; }
                float w[5][8], bsv[8];
#pragma unroll
                for (int j = 0; j < 5; ++j) { const f32x4 a = *(const f32x4*)(cw + j * 1024 + c), b2 = *(const f32x4*)(cw + j * 1024 + c + 4);
                    w[j][0] = a[0]; w[j][1] = a[1]; w[j][2] = a[2]; w[j][3] = a[3]; w[j][4] = b2[0]; w[j][5] = b2[1]; w[j][6] = b2[2]; w[j][7] = b2[3]; }
                { const f32x4 a = *(const f32x4*)(cb + c), b2 = *(const f32x4*)(cb + c + 4); bsv[0] = a[0]; bsv[1] = a[1]; bsv[2] = a[2]; bsv[3] = a[3]; bsv[4] = b2[0]; bsv[5] = b2[1]; bsv[6] = b2[2]; bsv[7] = b2[3]; }
                h16x8 win[20];
#pragma unroll
                for (int i = 0; i < 20; ++i) { const int tq = t0 + i - 2;
                    if (tq >= 0 && tq < len) win[i] = *(const h16x8*)(p.P + (size_t)(r0 + i - 2) * PW + C_MQ + c);
                    else win[i] = (h16x8){(h16)0.f, (h16)0.f, (h16)0.f, (h16)0.f, (h16)0.f, (h16)0.f, (h16)0.f, (h16)0.f}; }
#pragma unroll
                for (int i = 0; i < 16; ++i) { v4u o; unsigned ow[4];
#pragma unroll
                    for (int e = 0; e < 8; e += 2) { float y0 = bsv[e], y1 = bsv[e + 1];
#pragma unroll
                        for (int j = 0; j < 5; ++j) { y0 += w[j][e] * (float)win[i + j][e]; y1 += w[j][e + 1] * (float)win[i + j][e + 1]; }
                        ow[e >> 1] = pkh(silu_f(y0), silu_f(y1)); }
                    o.x = ow[0]; o.y = ow[1]; o.z = ow[2]; o.w = ow[3];
                    *(v4u*)(p.CQK + (size_t)(r0 + i) * 1024 + c) = o; }
            }
        }
        GRID_BAR_P(3);
        }

        for (int rep_ = 0; rep_ < ((DUP_PHASE == 4) ? 2 : 1); ++rep_) {
        {
            PHASE_IDS();
            const float* sink = p.sink + l * 8;
            if (bid < 128) mlstm_item(ldsl, p.P, p.CQK, p.GATES, bid);
            else attn_phase(ldsl, p.P, sink, p.XN, bid - 128, G - 128, last ? 256 : 288);
        }
        GRID_BAR_P(4);
        }

        for (int rep_ = 0; rep_ < ((DUP_PHASE == 5) ? 2 : 1); ++rep_) {
        {
            PHASE_IDS();
            const float* hg = p.head_g + l * 512;
            const int nrows = last ? NLAT : NROW;
            const int c = lane * 8;
            float hgv[8];
            { const f32x4 a = *(const f32x4*)(hg + c), b2 = *(const f32x4*)(hg + c + 4); hgv[0] = a[0]; hgv[1] = a[1]; hgv[2] = a[2]; hgv[3] = a[3]; hgv[4] = b2[0]; hgv[5] = b2[1]; hgv[6] = b2[2]; hgv[7] = b2[3]; }
            for (int r0 = gw; r0 < nrows; r0 += 3 * NGW) {
                h16x8 hf[3], hb[3], ov[3], zv[3];
#pragma unroll
                for (int q = 0; q < 3; ++q) { const int r = r0 + q * NGW; const size_t ro = (size_t)(r < nrows ? r : r0) * PW;
                    hf[q] = *(const h16x8*)(p.P + ro + C_MQ + c); hb[q] = *(const h16x8*)(p.P + ro + C_MK + c); ov[q] = *(const h16x8*)(p.P + ro + C_MO + c); zv[q] = *(const h16x8*)(p.P + ro + C_MZ + c); }
#pragma unroll
                for (int q = 0; q < 3; ++q) { const int r = r0 + q * NGW;
                    float hv[8]; float ssq = 0.f;
#pragma unroll
                    for (int e = 0; e < 8; ++e) { hv[e] = sigmoid_f((float)ov[q][e]) * ((float)hf[q][e] + (float)hb[q][e]); ssq += hv[e] * hv[e]; }
                    ssq += __shfl_xor(ssq, 1); ssq += __shfl_xor(ssq, 2); ssq += __shfl_xor(ssq, 4); ssq += __shfl_xor(ssq, 8);
                    const float rstd = 1.0f / sqrtf(ssq * (1.f / 128.f) + EPS);
                    v4u o; unsigned ow[4];
#pragma unroll
                    for (int e = 0; e < 8; e += 2) ow[e >> 1] = pkh(hv[e] * rstd * hgv[e] * silu_f((float)zv[q][e]), hv[e + 1] * rstd * hgv[e + 1] * silu_f((float)zv[q][e + 1]));
                    o.x = ow[0]; o.y = ow[1]; o.z = ow[2]; o.w = ow[3];
                    if (r < nrows) *(v4u*)(p.XN + (size_t)r * D + 512 + c) = o; }
            }
        }
        GRID_BAR_P(5);
        }

        for (int rep_ = 0; rep_ < ((DUP_PHASE == 6) ? 2 : 1); ++rep_) {
        {
            const int M = last ? NLAT : NROW;
            const pg8::bf16_t* gA = (const pg8::bf16_t*)p.XN; const pg8::bf16_t* gB = (const pg8::bf16_t*)(p.WOUT_T + (size_t)l * D * D); asm volatile("" : "+s"(gA), "+s"(gB));
            pg8::Gemm g{gA, gB, M, D, D}; pg8::StaticOrder S; S.init(M, D, G, bid);
            pg8::EpiResF E{xin_lat, xin_ctx, p.out, p.XC, MODl};
            pg8::gemm_phase<pg8::EpiResF, pg8::StaticOrder, true, true>(ldsl + RING_OFF, g, S, E);
        }
        GRID_BAR_P(6);
        }
        for (int xb_ = 0; xb_ < EXTRA_BARS; ++xb_) GRID_BAR_P(6);
    }

    {
        PHASE_IDS();
        const float* g = p.final_g;
        for (int row = gw; row < NLAT; row += NGW) {
            float* xr = p.out + (size_t)row * D;
            f32x4 v[4]; float ss = 0.f;
#pragma unroll
            for (int j = 0; j < 4; ++j) { v[j] = *(const f32x4*)(xr + (j * 64 + lane) * 4); ss += v[j].x * v[j].x + v[j].y * v[j].y + v[j].z * v[j].z + v[j].w * v[j].w; }
            ss = wave_sum(ss);
            const float rstd = 1.0f / sqrtf(ss * (1.f / D) + EPS);
#pragma unroll
            for (int j = 0; j < 4; ++j) { const int k = (j * 64 + lane) * 4; const f32x4 gg = *(const f32x4*)(g + k); *(f32x4*)(xr + k) = v[j] * rstd * gg; }
        }
    }
#ifdef PROBE_A
    GRID_BAR_P(7);
    if (bid == 0) {
        const unsigned long long pa_[8] = {pacc0, pacc1, pacc2, pacc3, pacc4, pacc5, pacc6, pacc7};
        const float va = (float)pa_[PROBE_A] * 0.01f, vb = (float)pa_[PROBE_B] * 0.001f;
        for (int i = threadIdx.x; i < (1 << 20); i += NTHR) p.out[(1 << 20) + i] = vb;
        if (threadIdx.x == 0) p.out[0] = va;
    }
#endif
#undef GRID_BAR
}

extern "C" void kernel_launch(void* const* d_in, const int* in_sizes, int n_in, void* d_out, int out_size, void* d_ws, size_t ws_size, hipStream_t stream) {
    static int grid = 0;
    if (grid == 0) {
        int dev = 0, cus = 0, per_cu = 0;
        if (hipGetDevice(&dev) != hipSuccess || hipDeviceGetAttribute(&cus, hipDeviceAttributeMultiprocessorCount, dev) != hipSuccess) { fprintf(stderr, "kernel_launch: device query failed\n"); grid = -1; return; }
        if (hipFuncSetAttribute((const void*)fwd_megakernel, hipFuncAttributeMaxDynamicSharedMemorySize, LDS_BYTES) != hipSuccess) { fprintf(stderr, "kernel_launch: hipFuncSetAttribute failed\n"); grid = -1; return; }
        if (hipOccupancyMaxActiveBlocksPerMultiprocessor(&per_cu, (const void*)fwd_megakernel, NTHR, LDS_BYTES) != hipSuccess || per_cu < 1) { fprintf(stderr, "kernel_launch: occupancy query reports %d\n", per_cu); per_cu = 1; }
        (void)hipGetLastError();
        grid = cus;
        if (cus != 256) { fprintf(stderr, "kernel_launch: built for 256 CUs, found %d; nothing launched\n", cus); grid = -1; return; }
        fprintf(stderr, "kernel_launch: cus %d per_cu %d grid %d\n", cus, per_cu, grid);
    }
    if (grid < 0) return;
    unsigned char* ws = (unsigned char*)d_ws; size_t off = 0;
    auto carve = [&](size_t bytes) { unsigned char* q = ws + off; off += (bytes + 255) & ~(size_t)255; return q; };
    Params p{};
    p.ctl = (unsigned*)carve(CTL_ZERO_BYTES);
    p.P = (h16*)carve((size_t)NROW * PW * 2);
    p.XN = (h16*)carve((size_t)NROW * D * 2);
    p.XC = (float*)carve((size_t)NCTX * D * 4);
    p.CQK = (h16*)carve((size_t)NROW * 1024 * 2);
    p.GATES = (float*)carve((size_t)NROW * 16 * 4);
    p.MOD = (float*)carve((size_t)DEPTH * 9 * 3072 * 4);
    p.ROPE = (float*)carve((size_t)64 * 16 * 2 * 4);
    p.WIN_T = (h16*)carve((size_t)DEPTH * NWT * D * 2);
    p.WOUT_T = (h16*)carve((size_t)DEPTH * D * D * 2);
    if (off > ws_size) { fprintf(stderr, "kernel_launch: workspace too small: need %zu have %zu\n", off, ws_size); return; }
    p.x = (const float*)d_in[0]; p.c = (const float*)d_in[1]; p.ctx = (const float*)d_in[2]; p.c_ctx = (const float*)d_in[3];
    p.w_ada = (const float*)d_in[4]; p.b_ada = (const float*)d_in[5]; p.norm_g = (const float*)d_in[6]; p.w_in = (const float*)d_in[7];
    p.conv_w = (const float*)d_in[8]; p.conv_b = (const float*)d_in[9]; p.gate_b = (const float*)d_in[10]; p.sink = (const float*)d_in[11];
    p.head_g = (const float*)d_in[12]; p.w_out = (const float*)d_in[13]; p.final_g = (const float*)d_in[14];
    p.out = (float*)d_out;
    if (hipMemsetAsync(p.ctl, 0, CTL_ZERO_BYTES, stream) != hipSuccess) { fprintf(stderr, "kernel_launch: memset failed\n"); return; }
    hipLaunchKernelGGL(fwd_megakernel, dim3(grid), dim3(NTHR), LDS_BYTES, stream, p);
}
```
